# Optimizing an MI355X kernel written in HIP

```python
import math
import jax, jax.numpy as jnp
from jax import lax
import numpy as np

D_MODEL = 1024
BATCH = 8
SEQ = 8192
DEPTH = 2

CHUNK = 64
D_FF = 2816
BRANCH_W = 512
N_BRANCH = 3
CONV_W = 3
H_RET = 4
DK_RET = BRANCH_W // H_RET
DV_RET = BRANCH_W // H_RET
H_ATT = 8
DH_ATT = BRANCH_W // H_ATT
N_PREV_CHUNKS = 8
BAND = (N_PREV_CHUNKS + 1) * CHUNK
REL_CLIP = 128
N_REL = 2 * REL_CLIP + 1
IN_COLS = 3 * BRANCH_W + 4 * BRANCH_W + 3 * BRANCH_W
EPS = 1e-6
NEG_INF = -1e30
ROPE_BASE = 10000.0

kernel_name = "hybrid_gated_conv_retention_chunkattn_macaron"


def _rmsnorm(x, w):
    xf = x.astype(jnp.float32)
    xf = xf * lax.rsqrt(jnp.mean(xf * xf, axis=-1, keepdims=True) + EPS)
    return (xf * w.astype(jnp.float32)).astype(x.dtype)


def _swiglu(h, w_gate, w_up, w_down):
    return (jax.nn.silu(h @ w_gate) * (h @ w_up)) @ w_down


def _short_gated_conv(u, b_gate, c_gate, conv_w):
    z = c_gate * u
    zp = jnp.pad(z, ((0, 0), (CONV_W - 1, 0), (0, 0)))
    s = z.shape[1]
    conv = sum(conv_w[j] * zp[:, j:j + s] for j in range(CONV_W))
    return b_gate * conv


def _rotary(x, cos, sin):
    half = x.shape[-1] // 2
    x1, x2 = x[..., :half], x[..., half:]
    c = cos[None, :, None, :]
    s_ = sin[None, :, None, :]
    return jnp.concatenate([x1 * c - x2 * s_, x1 * s_ + x2 * c], axis=-1).astype(x.dtype)


def _retention(q, k, v, g):
    bsz, s = q.shape[:2]
    nc = s // CHUNK
    log_gamma = jnp.log1p(-jnp.exp2(-5.0 - jnp.arange(H_RET, dtype=jnp.float32)))
    pos = jnp.arange(CHUNK, dtype=jnp.float32)
    d_intra = jnp.exp(log_gamma[:, None, None] * jnp.abs(pos[:, None] - pos[None, :]))
    q_decay = jnp.exp(log_gamma[:, None] * (pos + 1.0))
    k_decay = jnp.exp(log_gamma[:, None] * (CHUNK - 1.0 - pos))
    chunk_decay = jnp.exp(log_gamma * CHUNK)

    def to_chunks(t):
        return t.astype(jnp.float32).reshape(bsz, nc, CHUNK, H_RET, -1).transpose(1, 0, 3, 2, 4)

    qc = to_chunks(q) * (DK_RET ** -0.5)
    kc, vc = to_chunks(k), to_chunks(v)

    def step(state, qkv):
        qb, kb, vb = qkv
        inner = jnp.einsum('bhnk,bhmk->bhnm', qb, kb) * d_intra[None]
        o = jnp.einsum('bhnm,bhmv->bhnv', inner, vb) \
            + jnp.einsum('bhnk,bhkv->bhnv', qb * q_decay[None, :, :, None], state)
        state = state * chunk_decay[None, :, None, None] \
            + jnp.einsum('bhmk,bhmv->bhkv', kb * k_decay[None, :, :, None], vb)
        return state, o

    s0 = jnp.zeros((bsz, H_RET, DK_RET, DV_RET), jnp.float32)
    _, o = lax.scan(step, s0, (qc, kc, vc))
    o = o.transpose(1, 0, 3, 2, 4).reshape(bsz, s, H_RET, DV_RET)
    o = o * lax.rsqrt(jnp.mean(o * o, axis=-1, keepdims=True) + EPS)
    o = o.reshape(bsz, s, BRANCH_W).astype(g.dtype)
    return jax.nn.silu(g) * o


def _chunk_band_attention(q, k, v, rel_bias):
    bsz, s = q.shape[:2]
    nc = s // CHUNK
    pad = N_PREV_CHUNKS * CHUNK
    qc = q.reshape(bsz, nc, CHUNK, H_ATT, DH_ATT).transpose(1, 0, 3, 2, 4)
    kp = jnp.pad(k, ((0, 0), (pad, 0), (0, 0), (0, 0))).transpose(0, 2, 1, 3)
    vp = jnp.pad(v, ((0, 0), (pad, 0), (0, 0), (0, 0))).transpose(0, 2, 1, 3)
    n = jnp.arange(CHUNK)
    m = jnp.arange(BAND)
    dist = (pad + n)[:, None] - m[None, :]
    idx = jnp.clip(dist, -REL_CLIP, REL_CLIP) + REL_CLIP
    bias = rel_bias[:, idx].astype(jnp.float32)
    scale = DH_ATT ** -0.5

    def one_chunk(args):
        c, q_blk = args
        kb = lax.dynamic_slice_in_dim(kp, c * CHUNK, BAND, axis=2)
        vb = lax.dynamic_slice_in_dim(vp, c * CHUNK, BAND, axis=2)
        sc = jnp.einsum('bhnd,bhmd->bhnm', q_blk, kb).astype(jnp.float32) * scale + bias[None]
        valid = m >= (N_PREV_CHUNKS - c) * CHUNK
        sc = jnp.where(valid[None, None, None, :], sc, NEG_INF)
        p = jax.nn.softmax(sc, axis=-1).astype(vb.dtype)
        return jnp.einsum('bhnm,bhmd->bhnd', p, vb)

    out = lax.map(one_chunk, (jnp.arange(nc), qc))
    return out.transpose(1, 0, 3, 2, 4).reshape(bsz, s, BRANCH_W)


def setup_inputs(seed: int = 0) -> dict:
    key = jax.random.key(seed)
    ks = jax.random.split(key, 20)
    f32 = jnp.float32

    def w(k, shape, fan_in):
        return jax.random.normal(k, shape, f32) * (fan_in ** -0.5)

    def gain(k, shape):
        return 1.0 + 0.05 * jax.random.normal(k, shape, f32)

    return {
        "x": jax.random.normal(ks[0], (BATCH, SEQ, D_MODEL), f32),
        "ffn1_norm": gain(ks[1], (DEPTH, D_MODEL)),
        "ffn1_w_gate": w(ks[2], (DEPTH, D_MODEL, D_FF), D_MODEL),
        "ffn1_w_up": w(ks[3], (DEPTH, D_MODEL, D_FF), D_MODEL),
        "ffn1_w_down": w(ks[4], (DEPTH, D_FF, D_MODEL), D_FF),
        "mix_norm": gain(ks[5], (DEPTH, D_MODEL)),
        "w_in": w(ks[6], (DEPTH, D_MODEL, IN_COLS), D_MODEL),
        "conv_w": w(ks[7], (DEPTH, CONV_W, BRANCH_W), CONV_W),
        "rel_bias": 0.5 * jax.random.normal(ks[8], (DEPTH, H_ATT, N_REL), f32),
        "w_branch": w(ks[9], (DEPTH, N_BRANCH, BRANCH_W, D_MODEL), BRANCH_W),
        "w_merge_gate": w(ks[10], (DEPTH, N_BRANCH, D_MODEL, D_MODEL), D_MODEL),
        "w_out": w(ks[11], (DEPTH, D_MODEL, D_MODEL), D_MODEL),
        "ffn2_norm": gain(ks[12], (DEPTH, D_MODEL)),
        "ffn2_w_gate": w(ks[13], (DEPTH, D_MODEL, D_FF), D_MODEL),
        "ffn2_w_up": w(ks[14], (DEPTH, D_MODEL, D_FF), D_MODEL),
        "ffn2_w_down": w(ks[15], (DEPTH, D_FF, D_MODEL), D_FF),
        "final_norm": gain(ks[16], (D_MODEL,)),
    }


def reference(x, ffn1_norm, ffn1_w_gate, ffn1_w_up, ffn1_w_down, mix_norm, w_in, conv_w,
              rel_bias, w_branch, w_merge_gate, w_out, ffn2_norm, ffn2_w_gate, ffn2_w_up,
              ffn2_w_down, final_norm):
    bsz, s, _ = x.shape
    inv_freq = ROPE_BASE ** (-jnp.linspace(0.0, 1.0, DK_RET // 2, dtype=jnp.float32))
    ang = jnp.arange(s, dtype=jnp.float32)[:, None] * inv_freq[None, :]
    cos, sin = jnp.cos(ang), jnp.sin(ang)
    split_pts = [BRANCH_W * i for i in range(1, IN_COLS // BRANCH_W)]

    for l in range(DEPTH):
        x = x + 0.5 * _swiglu(_rmsnorm(x, ffn1_norm[l]), ffn1_w_gate[l], ffn1_w_up[l], ffn1_w_down[l])

        h = _rmsnorm(x, mix_norm[l])
        cols = jnp.split(h @ w_in[l], split_pts, axis=-1)
        cu, cb, cc, rq, rk, rv, rg, aq, ak, av = cols

        y_conv = _short_gated_conv(cu, cb, cc, conv_w[l])

        rq = _rotary(rq.reshape(bsz, s, H_RET, DK_RET), cos, sin)
        rk = _rotary(rk.reshape(bsz, s, H_RET, DK_RET), cos, sin)
        y_ret = _retention(rq, rk, rv.reshape(bsz, s, H_RET, DV_RET), rg)

        y_att = _chunk_band_attention(aq.reshape(bsz, s, H_ATT, DH_ATT),
                                      ak.reshape(bsz, s, H_ATT, DH_ATT),
                                      av.reshape(bsz, s, H_ATT, DH_ATT), rel_bias[l])

        merged = sum(jax.nn.sigmoid(h @ w_merge_gate[l, i]) * (y @ w_branch[l, i])
                     for i, y in enumerate((y_conv, y_ret, y_att)))
        x = x + merged @ w_out[l]

        x = x + 0.5 * _swiglu(_rmsnorm(x, ffn2_norm[l]), ffn2_w_gate[l], ffn2_w_up[l], ffn2_w_down[l])

    return _rmsnorm(x, final_norm)
```

```cpp
#include <hip/hip_runtime.h>
#include <hip/hip_cooperative_groups.h>
#include <cstdio>
#include <cstdint>
#include <cmath>
namespace cg = cooperative_groups;

#ifndef MK_MULTI
#define MK_MULTI 0
#endif

#ifndef PROBE
#define PROBE 0
#endif
#ifndef PH_MASK
#define PH_MASK 0x1ff
#endif
#define HAS(x) (((PH_MASK) >> (x)) & 1)
#define DI __device__ __forceinline__
#define LAS __attribute__((address_space(3)))
typedef unsigned short bf16_t;
typedef short bf16x8 __attribute__((ext_vector_type(8)));
typedef float f32x4 __attribute__((ext_vector_type(4)));
typedef float f32x16 __attribute__((ext_vector_type(16)));
typedef unsigned u32x4 __attribute__((ext_vector_type(4)));
typedef unsigned u32x2 __attribute__((ext_vector_type(2)));
typedef float f32x2_t __attribute__((ext_vector_type(2)));
typedef __bf16 bf16x2_t __attribute__((ext_vector_type(2)));

constexpr int DM = 1024, SEQ = 8192, NBATCH = 8, MTOK = NBATCH * SEQ, DFF = 2816, INC = 5120, GZ = 3072, NCAT = INC + GZ;
constexpr int XLD = 1088;
constexpr int HROWS = MTOK / 2;
constexpr float EPS = 1e-6f;
constexpr float LOG2E = 1.4426950408889634f;
constexpr size_t MiB = (size_t)1 << 20;
constexpr size_t WS_BAR = 0;
constexpr size_t WS_SSQ = 1 * MiB;
constexpr size_t WS_COS = 5 * MiB, WS_SIN = 7 * MiB;
constexpr size_t WS_T = 9 * MiB;
constexpr size_t WS_WT = 26 * MiB;
constexpr size_t WO1 = 0, WO2 = WO1 + (size_t)2 * DFF * DM * 2, WO3 = WO2 + (size_t)DM * DFF * 2, WO4 = WO3 + (size_t)NCAT * DM * 2,
                 WO5 = WO4 + (size_t)GZ * 512 * 2, WO6 = WO5 + (size_t)DM * DM * 2, WO7 = WO6 + (size_t)2 * DFF * DM * 2, WLAYER = WO7 + (size_t)DM * DFF * 2;
constexpr size_t WS_XB = 856 * MiB;
constexpr size_t WS_COLS = 272 * MiB;
constexpr size_t WS_G = 592 * MiB;
constexpr size_t WS_HID = 272 * MiB;
constexpr size_t WS_MB = 784 * MiB;
constexpr size_t WS_END = 992 * MiB;
static_assert(WS_WT + 2 * WLAYER <= WS_COLS && WS_MB + (size_t)HROWS * XLD * 2 <= WS_XB && WS_XB + (size_t)MTOK * XLD * 2 <= WS_END && WS_HID + (size_t)MTOK * DFF * 2 <= WS_END && WS_COLS + (size_t)HROWS * INC * 2 <= WS_G, "ws map");
#define XCD_BAR_WORDS 3456
constexpr int LDS_BYTES = 147456;

DI int otid() { int t = threadIdx.x; asm volatile("" : "+v"(t)); return t; }
DI int obid() { int b = blockIdx.x; asm volatile("" : "+s"(b)); return b; }
DI unsigned pk2(float lo, float hi) { f32x2_t v = {lo, hi}; bf16x2_t b = __builtin_convertvector(v, bf16x2_t); return __builtin_bit_cast(unsigned, b); }
DI float bflo(unsigned w) { return __uint_as_float(w << 16); }
DI float bfhi(unsigned w) { return __uint_as_float(w & 0xffff0000u); }
DI float bf2f(bf16_t u) { return __uint_as_float(((unsigned)u) << 16); }
DI bf16_t f2bf(float f) { return (bf16_t)(pk2(f, 0.f) & 0xffffu); }
DI float ex2(float x) { return __builtin_amdgcn_exp2f(x); }
DI float sigm(float v) { return __builtin_amdgcn_rcpf(1.f + ex2(-LOG2E * v)); }
DI int crow(int reg, int h) { return (reg & 3) + 8 * (reg >> 2) + 4 * h; }
#define MFMA32(a, b, c) __builtin_amdgcn_mfma_f32_32x32x16_bf16((a), (b), (c), 0, 0, 0)
DI bf16x8 pack8(float a0, float a1, float a2, float a3, float a4, float a5, float a6, float a7) {
    u32x4 p; p.x = pk2(a0, a1); p.y = pk2(a2, a3); p.z = pk2(a4, a5); p.w = pk2(a6, a7); return __builtin_bit_cast(bf16x8, p);
}
typedef short v4i16_t __attribute__((ext_vector_type(4)));
DI v4i16_t trd(const LAS bf16_t* p) { return __builtin_amdgcn_ds_read_tr16_b64_v4i16((LAS v4i16_t*)p); }
DI bf16x8 cat8(v4i16_t lo, v4i16_t hi) { return __builtin_shufflevector(lo, hi, 0, 1, 2, 3, 4, 5, 6, 7); }
DI float row_rstd(const float* ssq, int grow) {
    const f32x4* p = (const f32x4*)(ssq + (size_t)grow * 16); const f32x4 a = p[0], b = p[1], c = p[2], d = p[3];
    const float s = ((a.x + a.y) + (a.z + a.w)) + ((b.x + b.y) + (b.z + b.w)) + ((c.x + c.y) + (c.z + c.w)) + ((d.x + d.y) + (d.z + d.w));
    return __builtin_amdgcn_rsqf(s * (1.f / DM) + EPS);
}

namespace pg8 {
constexpr int BM = 256, BK = 64, HALF = 128, HTB = HALF * BK * 2, STAGE_BYTES = 8 * HTB, NXCD = 8, WGM = 8;
__host__ __device__ __forceinline__ int lds_byte(int r, int c) { const int st = (r >> 4) * 2 + (c >> 5), rr = r & 15, cc = c & 31, ob = rr * 64 + cc * 2; return st * 1024 + (ob ^ (((ob >> 9) & 1) << 5)); }
__host__ __device__ __forceinline__ void stage_rc(int b, int& R, int& C) { const int st = b / 1024, sb = b % 1024, swz = sb ^ (((sb >> 9) & 1) << 5); R = (st >> 1) * 16 + swz / 64; C = (st & 1) * 32 + (swz % 64) / 2; }
__host__ __device__ __forceinline__ int perm32(int rho) { const int n = rho >> 4, i = rho & 15; return 8 * (i >> 2) + 4 * n + (i & 3); }
struct Unit { int pm, pn; };
struct Gemm { const bf16_t* A; const bf16_t* Bt; int K, lda; };
struct StaticOrder {
    int nM, nN, nwg, G, c;
    __device__ void init(int M, int N, int G_, int c_, int br3_ = 0) { nM = M / BM; nN = N / BM; nwg = nM * nN; G = G_; c = c_; br3 = br3_; }
    int br3;
    __device__ bool next(int i, Unit& u) const {
        if (br3) { const int b = i % 3; if (!next1(i / 3, u)) return false; u.pn += b * nN; return true; }
        return next1(i, u);
    }
    __device__ bool next1(int i, Unit& u) const {
        const long L = (long)i * G + c; if (L >= nwg) return false;
        int wgid = (int)L; { const int q = nwg / NXCD, r = nwg % NXCD, xcd = wgid % NXCD, off = wgid / NXCD; wgid = (xcd < r ? xcd * (q + 1) : r * (q + 1) + (xcd - r) * q) + off; }
        const int nig = WGM * nN, gid = wgid / nig, fm = gid * WGM, gsz = (nM - fm) < WGM ? (nM - fm) : WGM;
        u.pm = fm + ((wgid % nig) % gsz); u.pn = (wgid % nig) / gsz; return true;
    }
};
template <class Epi, bool BR = false>
DI void gemm_phase(LAS unsigned char* lds, const Gemm g, const StaticOrder& S, const Epi& E) {
    const int tid = otid(), wid = __builtin_amdgcn_readfirstlane(tid >> 6), lane = tid & 63, wr = wid >> 2, wc = wid & 3, fr = lane & 15, fq = lane >> 4;
    const int K = g.K, nt = K / BK, lda = g.lda;
    unsigned voffA[2], voffB[2];
#pragma unroll
    for (int i = 0; i < 2; ++i) { int R, C; stage_rc(tid * 16 + i * 8192, R, C); const int Rb = (R & ~31) + perm32(R & 31);
        voffA[i] = (unsigned)(R * lda + C) * 2u; voffB[i] = (unsigned)(Rb * K + C) * 2u; }
    const size_t kstep = (size_t)(BK * 2);
    const size_t hA = (size_t)HALF * lda * 2, tA = 2 * hA;
    const size_t hB = (size_t)HALF * K * 2, tB = 2 * hB;
    const unsigned ldsw = (unsigned)wid * 1024u;
    const int aoff = lds_byte(wr * 64 + fr, fq * 8), boff = lds_byte(wc * 32 + fr, fq * 8);
#define PG8_SA(b, h) (((b) * 2 + (h)) * HTB)
#define PG8_SB(b, h) ((4 + (b) * 2 + (h)) * HTB)
#define PG8_STAGE(bufoff, gbase, voff) do { _Pragma("unroll") for (int _i = 0; _i < 2; ++_i) \
        __builtin_amdgcn_global_load_lds((const unsigned*)((const char*)(gbase) + (voff)[_i]), (LAS unsigned*)(lds + (bufoff) + ldsw + _i * 8192), 16, 0, 0); } while (0)
#define PG8_LDA(dst, b, h) do { _Pragma("unroll") for (int m = 0; m < 4; ++m) _Pragma("unroll") for (int k = 0; k < 2; ++k) dst[m][k] = *(const LAS bf16x8*)(lds + PG8_SA(b, h) + aoff + m * 2048 + k * 1024); } while (0)
#define PG8_LDB(dst, b, h) do { _Pragma("unroll") for (int n = 0; n < 2; ++n) _Pragma("unroll") for (int k = 0; k < 2; ++k) dst[n][k] = *(const LAS bf16x8*)(lds + PG8_SB(b, h) + boff + n * 2048 + k * 1024); } while (0)
#define PG8_MMA(ai, bj, At, Bt) do { __builtin_amdgcn_s_setprio(1); _Pragma("unroll") for (int m = 0; m < 4; ++m) _Pragma("unroll") for (int n = 0; n < 2; ++n) _Pragma("unroll") for (int k = 0; k < 2; ++k) \
        acc[ai][bj][m][n] = __builtin_amdgcn_mfma_f32_16x16x32_bf16(Bt[n][k], At[m][k], acc[ai][bj][m][n], 0, 0, 0); __builtin_amdgcn_s_setprio(0); } while (0)
#define PG8_WAIT_V(n) asm volatile("s_waitcnt vmcnt(" #n ")" ::: "memory")
#define PG8_WAIT_L(n) asm volatile("s_waitcnt lgkmcnt(" #n ")" ::: "memory")
#define PG8_BAR __builtin_amdgcn_s_barrier()
#define PG8_SCHED __builtin_amdgcn_sched_barrier(0)
#define PG8_ACOL(u) (BR ? (((u).pn >> 2) == 0 ? 512 : (((u).pn >> 2) == 1 ? 3072 : 3584)) : 0)
    Unit cur, nxt; int ui = 0;
    if (!S.next(0, cur)) return;
    f32x4 acc[2][2][4][2];
#pragma unroll
    for (int a = 0; a < 2; ++a)
#pragma unroll
        for (int b = 0; b < 2; ++b)
#pragma unroll
            for (int m = 0; m < 4; ++m)
#pragma unroll
                for (int n = 0; n < 2; ++n) acc[a][b][m][n] = (f32x4){0.f, 0.f, 0.f, 0.f};
    bf16x8 At[4][2], B0[2][2], B1[2][2];
    const char* cA = (const char*)g.A + (size_t)cur.pm * tA + (size_t)PG8_ACOL(cur) * 2; const char* cB = (const char*)g.Bt + (size_t)cur.pn * tB;
    PG8_STAGE(PG8_SB(0, 0), cB, voffB); PG8_STAGE(PG8_SB(0, 1), cB + hB, voffB); PG8_STAGE(PG8_SA(0, 0), cA, voffA); PG8_STAGE(PG8_SA(0, 1), cA + hA, voffA);
    if (wr == 1) PG8_BAR;
    PG8_WAIT_V(2); PG8_BAR;
    PG8_STAGE(PG8_SB(1, 0), cB + kstep, voffB); PG8_STAGE(PG8_SA(1, 0), cA + kstep, voffA); PG8_STAGE(PG8_SB(1, 1), cB + hB + kstep, voffB);
    PG8_WAIT_V(6); PG8_BAR;
    for (;;) {
        const bool has_next = S.next(ui + 1, nxt);
        const char* nA = has_next ? (const char*)g.A + (size_t)nxt.pm * tA + (size_t)PG8_ACOL(nxt) * 2 : cA; const char* nB = has_next ? (const char*)g.Bt + (size_t)nxt.pn * tB : cB;
        for (int t = 0; t < nt; t += 2) {
            const bool last = (t == nt - 2);
            const char* a1 = cA + (size_t)(t + 1) * kstep;
            const char* a2 = last ? nA : cA + (size_t)(t + 2) * kstep; const char* b2 = last ? nB : cB + (size_t)(t + 2) * kstep;
            const char* a3 = a2 + kstep; const char* b3 = b2 + kstep;
            PG8_LDB(B0, 0, 0); PG8_LDB(B1, 0, 1); PG8_SCHED; PG8_LDA(At, 0, 0); PG8_STAGE(PG8_SA(1, 1), a1 + hA, voffA);
            PG8_WAIT_V(8); PG8_WAIT_L(0); PG8_BAR; PG8_MMA(0, 0, At, B0); PG8_MMA(0, 1, At, B1); PG8_BAR; PG8_SCHED;
            PG8_LDA(At, 0, 1); PG8_STAGE(PG8_SB(0, 0), b2, voffB); PG8_STAGE(PG8_SB(0, 1), b2 + hB, voffB); PG8_STAGE(PG8_SA(0, 0), a2, voffA);
            PG8_WAIT_V(8); PG8_WAIT_L(0); PG8_BAR; PG8_MMA(1, 0, At, B0); PG8_MMA(1, 1, At, B1); PG8_BAR; PG8_SCHED;
            PG8_LDB(B0, 1, 0); PG8_LDB(B1, 1, 1); PG8_SCHED; PG8_LDA(At, 1, 0); PG8_STAGE(PG8_SA(0, 1), a2 + hA, voffA);
            PG8_WAIT_V(8); PG8_WAIT_L(0); PG8_BAR; PG8_MMA(0, 0, At, B0); PG8_MMA(0, 1, At, B1); PG8_BAR; PG8_SCHED;
            PG8_LDA(At, 1, 1); PG8_STAGE(PG8_SB(1, 0), b3, voffB); PG8_STAGE(PG8_SB(1, 1), b3 + hB, voffB); PG8_STAGE(PG8_SA(1, 0), a3, voffA);
            PG8_WAIT_V(8); PG8_WAIT_L(0); PG8_BAR; PG8_MMA(1, 0, At, B0); PG8_MMA(1, 1, At, B1); PG8_BAR; PG8_SCHED;
        }
        if (wr == 0) PG8_BAR;
        E(acc, cur, wr, wc, fr, fq);
        if (!has_next) break;
#pragma unroll
        for (int a = 0; a < 2; ++a)
#pragma unroll
            for (int b = 0; b < 2; ++b)
#pragma unroll
                for (int m = 0; m < 4; ++m)
#pragma unroll
                    for (int n = 0; n < 2; ++n) acc[a][b][m][n] = (f32x4){0.f, 0.f, 0.f, 0.f};
        cur = nxt; cA = nA; cB = nB; ++ui;
        if (wr == 1) PG8_BAR;
    }
    PG8_WAIT_V(0);
    PG8_BAR;
#undef PG8_SA
#undef PG8_SB
#undef PG8_STAGE
#undef PG8_LDA
#undef PG8_LDB
#undef PG8_MMA
#undef PG8_WAIT_V
#undef PG8_WAIT_L
#undef PG8_BAR
#undef PG8_SCHED
#undef PG8_ACOL
}

struct EpiGateUp {
    bf16_t* H; const float* ssq;
    DI void operator()(const f32x4 (&acc)[2][2][4][2], const Unit& u, int wr, int wc, int fr, int fq) const {
        const int lane = fr + 16 * fq;
        const float rs0 = row_rstd(ssq, u.pm * BM + wr * 64 + lane), rs1 = row_rstd(ssq, u.pm * BM + HALF + wr * 64 + lane);
        asm volatile("" ::: "memory");
#pragma unroll
        for (int ai = 0; ai < 2; ++ai)
#pragma unroll
            for (int m = 0; m < 4; ++m) {
                const int r = u.pm * BM + ai * HALF + wr * 64 + m * 16 + fr; const float rs = __shfl(ai ? rs1 : rs0, m * 16 + fr);
                float hv[8];
#pragma unroll
                for (int n = 0; n < 2; ++n)
#pragma unroll
                    for (int j = 0; j < 4; ++j) { const float gt = acc[ai][0][m][n][j] * rs, up = acc[ai][1][m][n][j] * rs; hv[4 * n + j] = gt * sigm(gt) * up; }
                u32x4 w; w.x = pk2(hv[0], hv[1]); w.y = pk2(hv[2], hv[3]); w.z = pk2(hv[4], hv[5]); w.w = pk2(hv[6], hv[7]);
                *(u32x4*)(H + (size_t)r * DFF + u.pn * 128 + wc * 32 + 8 * fq) = w;
            }
    }
};
struct EpiResid {
    const float* xin32; float* xout32; bf16_t* xb; float* ssq; float alpha; int row0; int dry;
    DI void operator()(const f32x4 (&acc)[2][2][4][2], const Unit& u, int wr, int wc, int fr, int fq) const {
#pragma unroll
        for (int ai = 0; ai < 2; ++ai) {
            f32x4 v[4][2][2];
            if (xin32) {
#pragma unroll
                for (int m = 0; m < 4; ++m)
#pragma unroll
                    for (int bj = 0; bj < 2; ++bj) { const size_t off = (size_t)(row0 + u.pm * BM + ai * HALF + wr * 64 + m * 16 + fr) * DM + u.pn * BM + bj * HALF + wc * 32 + 8 * fq;
                        v[m][bj][0] = *(const f32x4*)(xin32 + off); v[m][bj][1] = *(const f32x4*)(xin32 + off + 4); }
            } else {
                u32x4 xv[4][2];
#pragma unroll
                for (int m = 0; m < 4; ++m)
#pragma unroll
                    for (int bj = 0; bj < 2; ++bj) xv[m][bj] = *(const u32x4*)(xb + (size_t)(row0 + u.pm * BM + ai * HALF + wr * 64 + m * 16 + fr) * XLD + u.pn * BM + bj * HALF + wc * 32 + 8 * fq);
#pragma unroll
                for (int m = 0; m < 4; ++m)
#pragma unroll
                    for (int bj = 0; bj < 2; ++bj) { const u32x4 t = xv[m][bj]; v[m][bj][0] = (f32x4){bflo(t.x), bfhi(t.x), bflo(t.y), bfhi(t.y)}; v[m][bj][1] = (f32x4){bflo(t.z), bfhi(t.z), bflo(t.w), bfhi(t.w)}; }
            }
            asm volatile("" ::: "memory");
#pragma unroll
            for (int m = 0; m < 4; ++m) {
                const int r = row0 + u.pm * BM + ai * HALF + wr * 64 + m * 16 + fr; float sq = 0.f;
#pragma unroll
                for (int bj = 0; bj < 2; ++bj) {
                    const size_t off = (size_t)r * DM + u.pn * BM + bj * HALF + wc * 32 + 8 * fq, offb = (size_t)r * XLD + u.pn * BM + bj * HALF + wc * 32 + 8 * fq;
                    const f32x4 v0 = v[m][bj][0] + acc[ai][bj][m][0] * alpha, v1 = v[m][bj][1] + acc[ai][bj][m][1] * alpha;
                    if (!dry) {
                        if (xout32) { *(f32x4*)(xout32 + off) = v0; *(f32x4*)(xout32 + off + 4) = v1; }
                        else { u32x4 w; w.x = pk2(v0[0], v0[1]); w.y = pk2(v0[2], v0[3]); w.z = pk2(v1[0], v1[1]); w.w = pk2(v1[2], v1[3]); *(u32x4*)(xb + offb) = w; }
                    }
                    sq += (v0[0] * v0[0] + v0[1] * v0[1]) + (v0[2] * v0[2] + v0[3] * v0[3]) + (v1[0] * v1[0] + v1[1] * v1[1]) + (v1[2] * v1[2] + v1[3] * v1[3]);
                }
                sq += __shfl_xor(sq, 16); sq += __shfl_xor(sq, 32);
                if (fq == 0 && !dry) ssq[(size_t)r * 16 + u.pn * 4 + wc] = sq;
            }
            asm volatile("" ::: "memory");
        }
    }
};
struct EpiInProj {
    bf16_t* cols; bf16_t* G; const float* ssq; const float* cosT; const float* sinT; int row0;
    DI void operator()(const f32x4 (&acc)[2][2][4][2], const Unit& u, int wr, int wc, int fr, int fq) const {
        const int pn = u.pn, lane = fr + 16 * fq;
        const float rs0 = row_rstd(ssq, row0 + u.pm * BM + wr * 64 + lane), rs1 = row_rstd(ssq, row0 + u.pm * BM + HALF + wr * 64 + lane);
        asm volatile("" ::: "memory");
#pragma unroll
        for (int ai = 0; ai < 2; ++ai)
#pragma unroll
            for (int m = 0; m < 4; ++m) {
                const int rl = u.pm * BM + ai * HALF + wr * 64 + m * 16 + fr; const float rs = __shfl(ai ? rs1 : rs0, m * 16 + fr);
                if (pn >= 20) {
#pragma unroll
                    for (int bj = 0; bj < 2; ++bj) { const f32x4 a0 = acc[ai][bj][m][0] * rs, a1 = acc[ai][bj][m][1] * rs;
                        u32x4 w; w.x = pk2(sigm(a0[0]), sigm(a0[1])); w.y = pk2(sigm(a0[2]), sigm(a0[3])); w.z = pk2(sigm(a1[0]), sigm(a1[1])); w.w = pk2(sigm(a1[2]), sigm(a1[3]));
                        *(u32x4*)(G + (size_t)rl * GZ + (pn - 20) * BM + bj * HALF + wc * 32 + 8 * fq) = w; }
                } else if (pn >= 6 && pn < 10) {
                    const int pos = (row0 + rl) & (SEQ - 1), hh = wc >> 1, dd0 = 32 * (wc & 1) + 8 * fq;
                    const f32x4 c0 = *(const f32x4*)(cosT + pos * 64 + dd0), c1 = *(const f32x4*)(cosT + pos * 64 + dd0 + 4);
                    const f32x4 s0 = *(const f32x4*)(sinT + pos * 64 + dd0), s1 = *(const f32x4*)(sinT + pos * 64 + dd0 + 4);
                    const f32x4 x10 = acc[ai][0][m][0] * rs, x11 = acc[ai][0][m][1] * rs, x20 = acc[ai][1][m][0] * rs, x21 = acc[ai][1][m][1] * rs;
                    const f32x4 y10 = x10 * c0 - x20 * s0, y11 = x11 * c1 - x21 * s1, y20 = x10 * s0 + x20 * c0, y21 = x11 * s1 + x21 * c1;
                    u32x4 w1, w2; w1.x = pk2(y10[0], y10[1]); w1.y = pk2(y10[2], y10[3]); w1.z = pk2(y11[0], y11[1]); w1.w = pk2(y11[2], y11[3]);
                    w2.x = pk2(y20[0], y20[1]); w2.y = pk2(y20[2], y20[3]); w2.z = pk2(y21[0], y21[1]); w2.w = pk2(y21[2], y21[3]);
                    bf16_t* p = cols + (size_t)rl * INC + pn * BM + hh * 128 + dd0;
                    *(u32x4*)p = w1; *(u32x4*)(p + 64) = w2;
                } else {
#pragma unroll
                    for (int bj = 0; bj < 2; ++bj) { const f32x4 a0 = acc[ai][bj][m][0] * rs, a1 = acc[ai][bj][m][1] * rs;
                        u32x4 w; w.x = pk2(a0[0], a0[1]); w.y = pk2(a0[2], a0[3]); w.z = pk2(a1[0], a1[1]); w.w = pk2(a1[2], a1[3]);
                        *(u32x4*)(cols + (size_t)rl * INC + pn * BM + bj * HALF + wc * 32 + 8 * fq) = w; }
                }
            }
    }
};
struct EpiBranch {
    const bf16_t* Gt; bf16_t* Mb; int dry;
    DI void operator()(const f32x4 (&acc)[2][2][4][2], const Unit& u, int wr, int wc, int fr, int fq) const {
        const int br = u.pn >> 2, pc = u.pn & 3;
#pragma unroll
        for (int ai = 0; ai < 2; ++ai) {
            u32x4 gv[4][2], mv[4][2];
#pragma unroll
            for (int m = 0; m < 4; ++m)
#pragma unroll
                for (int bj = 0; bj < 2; ++bj) { const int rl = u.pm * BM + ai * HALF + wr * 64 + m * 16 + fr;
                    gv[m][bj] = *(const u32x4*)(Gt + (size_t)rl * GZ + u.pn * BM + bj * HALF + wc * 32 + 8 * fq);
                    if (br) mv[m][bj] = *(const u32x4*)(Mb + (size_t)rl * XLD + pc * BM + bj * HALF + wc * 32 + 8 * fq); else mv[m][bj] = (u32x4){0u, 0u, 0u, 0u}; }
            asm volatile("" ::: "memory");
#pragma unroll
            for (int m = 0; m < 4; ++m)
#pragma unroll
                for (int bj = 0; bj < 2; ++bj) {
                    const int rl = u.pm * BM + ai * HALF + wr * 64 + m * 16 + fr; const u32x4 g = gv[m][bj], mm = mv[m][bj];
                    const f32x4 a0 = acc[ai][bj][m][0], a1 = acc[ai][bj][m][1];
                    u32x4 w; w.x = pk2(bflo(mm.x) + bflo(g.x) * a0[0], bfhi(mm.x) + bfhi(g.x) * a0[1]); w.y = pk2(bflo(mm.y) + bflo(g.y) * a0[2], bfhi(mm.y) + bfhi(g.y) * a0[3]);
                    w.z = pk2(bflo(mm.z) + bflo(g.z) * a1[0], bfhi(mm.z) + bfhi(g.z) * a1[1]); w.w = pk2(bflo(mm.w) + bflo(g.w) * a1[2], bfhi(mm.w) + bfhi(g.w) * a1[3]);
                    if (!dry) *(u32x4*)(Mb + (size_t)rl * XLD + pc * BM + bj * HALF + wc * 32 + 8 * fq) = w;
                }
            asm volatile("" ::: "memory");
        }
    }
};
}

struct Params { const float* in[17]; float* out; unsigned char* ws; int lo, hi; float invf[64]; };
enum { I_X = 0, I_F1N, I_F1G, I_F1U, I_F1D, I_MN, I_WIN, I_CW, I_RB, I_WB, I_WMG, I_WO, I_F2N, I_F2G, I_F2U, I_F2D, I_FN };

struct WJob { const float* src; int ld, K, N; const float* gain; bf16_t* dst; int Kdst, koff, mode, rowoff; };
DI WJob get_job(const Params& P, int l, int j) {
    WJob w; unsigned char* wl = P.ws + WS_WT + (size_t)l * WLAYER;
    w.gain = nullptr; w.koff = 0; w.mode = 0; w.rowoff = 0;
    if (j == 0 || j == 1 || j == 11 || j == 12) {
        const bool second = j >= 11; const bool up = (j == 1 || j == 12);
        w.src = P.in[second ? (up ? I_F2U : I_F2G) : (up ? I_F1U : I_F1G)] + (size_t)l * DM * DFF; w.ld = DFF; w.K = DM; w.N = DFF;
        w.gain = P.in[second ? I_F2N : I_F1N] + l * DM; w.dst = (bf16_t*)(wl + (second ? WO6 : WO1)); w.Kdst = DM; w.mode = 1; w.rowoff = up ? 128 : 0;
    } else if (j == 2 || j == 13) {
        w.src = P.in[j == 2 ? I_F1D : I_F2D] + (size_t)l * DFF * DM; w.ld = DM; w.K = DFF; w.N = DM; w.dst = (bf16_t*)(wl + (j == 2 ? WO2 : WO7)); w.Kdst = DFF;
    } else if (j == 3) {
        w.src = P.in[I_WIN] + (size_t)l * DM * INC; w.ld = INC; w.K = DM; w.N = INC; w.gain = P.in[I_MN] + l * DM; w.dst = (bf16_t*)(wl + WO3); w.Kdst = DM; w.mode = 2;
    } else if (j >= 4 && j <= 6) {
        const int i = j - 4; w.src = P.in[I_WMG] + (size_t)(l * 3 + i) * DM * DM; w.ld = DM; w.K = DM; w.N = DM; w.gain = P.in[I_MN] + l * DM; w.dst = (bf16_t*)(wl + WO3); w.Kdst = DM; w.rowoff = INC + i * DM;
    } else if (j >= 7 && j <= 9) {
        const int i = j - 7; w.src = P.in[I_WB] + (size_t)(l * 3 + i) * 512 * DM; w.ld = DM; w.K = 512; w.N = DM; w.dst = (bf16_t*)(wl + WO4); w.Kdst = 512; w.rowoff = i * DM;
    } else {
        w.src = P.in[I_WO] + (size_t)l * DM * DM; w.ld = DM; w.K = DM; w.N = DM; w.dst = (bf16_t*)(wl + WO5); w.Kdst = DM;
    }
    return w;
}
DI void wt_tile(const WJob& w, int tile, LAS float* scr, int tid) {
    const int nbn = w.N / 64, kb = tile / nbn, nb = tile % nbn, k0 = kb * 64, n0 = nb * 64;
    float scale = 1.f;
    if (w.mode == 2) { if (n0 >= 1536 && n0 < 2048) scale = 0.08838834764831845f; else if (n0 >= 3584 && n0 < 4096) scale = 0.125f * LOG2E; }
#pragma unroll
    for (int i = 0; i < 8; ++i) { const int kk = i * 8 + (tid >> 6), nn = tid & 63;
        float v = w.src[(size_t)(k0 + kk) * w.ld + n0 + nn] * scale; if (w.gain) v *= w.gain[k0 + kk];
        scr[kk * 65 + nn] = v; }
    __syncthreads();
    { const int n = tid >> 3, kc = tid & 7, ng = n0 + n; int row;
      if (w.mode == 1) row = (ng >> 7) * 256 + w.rowoff + (ng & 127);
      else if (w.mode == 2 && ng >= 1536 && ng < 2560) { const int pnn = ng >> 8, cl = ng & 255, hh = cl >> 7, d = cl & 127; row = pnn * 256 + (d < 64 ? hh * 64 + d : 128 + hh * 64 + (d - 64)); }
      else row = w.rowoff + ng;
      const LAS float* s = scr + (8 * kc) * 65 + n;
      u32x4 o; o.x = pk2(s[0], s[65]); o.y = pk2(s[2 * 65], s[3 * 65]); o.z = pk2(s[4 * 65], s[5 * 65]); o.w = pk2(s[6 * 65], s[7 * 65]);
      *(u32x4*)(w.dst + (size_t)row * w.Kdst + w.koff + k0 + 8 * kc) = o; }
    __syncthreads();
}
DI float wave_sum(float v) {
#pragma unroll
    for (int o = 1; o < 64; o <<= 1) v += __shfl_xor(v, o);
    return v;
}
DI void prologue(const Params& P, LAS unsigned char* lds) {
    const int tid = otid(), lane = tid & 63, wid = tid >> 6, G = gridDim.x;
    LAS float* scr = (LAS float*)lds;
    for (int l = 0; l < 2; ++l)
        for (int j = 0; j < 14; ++j) { const WJob w = get_job(P, l, j); const int ntile = (w.K / 64) * (w.N / 64);
            for (int t = obid(); t < ntile; t += G) wt_tile(w, t, scr, tid); }
    if (blockIdx.x == 0) { unsigned* bw = (unsigned*)(P.ws + WS_BAR); for (int i = tid; i < XCD_BAR_WORDS; i += 512) bw[i] = 0u; }
    const float* x = P.in[I_X]; bf16_t* xb = (bf16_t*)(P.ws + WS_XB); float* ssq = (float*)(P.ws + WS_SSQ);
    for (int row = obid() * 8 + wid; row < MTOK; row += G * 8) {
        const f32x4* xr = (const f32x4*)(x + (size_t)row * DM) + lane; float s = 0.f;
        u32x2* o8 = (u32x2*)(xb + (size_t)row * XLD) + lane;
#pragma unroll
        for (int j = 0; j < 4; ++j) { const f32x4 v = xr[64 * j]; s += (v.x * v.x + v.y * v.y) + (v.z * v.z + v.w * v.w); u32x2 o; o.x = pk2(v.x, v.y); o.y = pk2(v.z, v.w); o8[64 * j] = o; }
        s = wave_sum(s);
        if (lane < 16) ssq[(size_t)row * 16 + lane] = lane == 0 ? s : 0.f;
    }
    float* cosT = (float*)(P.ws + WS_COS); float* sinT = (float*)(P.ws + WS_SIN);
    for (int idx = obid() * 512 + tid; idx < SEQ * 64; idx += G * 512) {
        const int pos = idx >> 6, i = idx & 63;
        const float ang = (float)pos * P.invf[i];
        const double rev = (double)ang * 0.15915494309189535; const float fr = (float)(rev - floor(rev));
        cosT[idx] = __builtin_amdgcn_cosf(fr); sinT[idx] = __builtin_amdgcn_sinf(fr);
    }
}

DI void conv_phase(const Params& P, int l, int dry = 0) {
    bf16_t* cols = (bf16_t*)(P.ws + WS_COLS); const float* cw = P.in[I_CW] + l * 3 * 512;
    const int gt = obid() * 512 + otid(), stride = gridDim.x * 512;
    for (int it = gt; it < (HROWS / 8) * 64; it += stride) {
        const int cg8 = it & 63, t0 = (it >> 6) * 8, ch = cg8 * 8;
        float w0[8], w1[8], w2[8], z1[8], z2[8];
#pragma unroll
        for (int e = 0; e < 8; ++e) { w0[e] = cw[ch + e]; w1[e] = cw[512 + ch + e]; w2[e] = cw[1024 + ch + e]; z1[e] = 0.f; z2[e] = 0.f; }
        if ((t0 & (SEQ - 1)) != 0) {
            const u32x4 u1 = *(const u32x4*)(cols + (size_t)(t0 - 1) * INC + ch), c1 = *(const u32x4*)(cols + (size_t)(t0 - 1) * INC + 1024 + ch);
            const u32x4 u2 = *(const u32x4*)(cols + (size_t)(t0 - 2) * INC + ch), c2 = *(const u32x4*)(cols + (size_t)(t0 - 2) * INC + 1024 + ch);
#pragma unroll
            for (int e = 0; e < 4; ++e) { z1[2 * e] = bflo(u1[e]) * bflo(c1[e]); z1[2 * e + 1] = bfhi(u1[e]) * bfhi(c1[e]); z2[2 * e] = bflo(u2[e]) * bflo(c2[e]); z2[2 * e + 1] = bfhi(u2[e]) * bfhi(c2[e]); }
        }
#pragma unroll
        for (int e4 = 0; e4 < 8; e4 += 4) {
            u32x4 uu[4], bb[4], cc[4];
#pragma unroll
            for (int q = 0; q < 4; ++q) { const bf16_t* rp = cols + (size_t)(t0 + e4 + q) * INC + ch; uu[q] = *(const u32x4*)rp; bb[q] = *(const u32x4*)(rp + 512); cc[q] = *(const u32x4*)(rp + 1024); }
            asm volatile("" ::: "memory");
#pragma unroll
            for (int q = 0; q < 4; ++q) {
                float y[8];
#pragma unroll
                for (int e = 0; e < 4; ++e) {
                    const float za = bflo(uu[q][e]) * bflo(cc[q][e]), zb = bfhi(uu[q][e]) * bfhi(cc[q][e]);
                    y[2 * e] = bflo(bb[q][e]) * (w0[2 * e] * z2[2 * e] + w1[2 * e] * z1[2 * e] + w2[2 * e] * za);
                    y[2 * e + 1] = bfhi(bb[q][e]) * (w0[2 * e + 1] * z2[2 * e + 1] + w1[2 * e + 1] * z1[2 * e + 1] + w2[2 * e + 1] * zb);
                    z2[2 * e] = z1[2 * e]; z2[2 * e + 1] = z1[2 * e + 1]; z1[2 * e] = za; z1[2 * e + 1] = zb;
                }
                u32x4 o; o.x = pk2(y[0], y[1]); o.y = pk2(y[2], y[3]); o.z = pk2(y[4], y[5]); o.w = pk2(y[6], y[7]);
                if (!dry) *(u32x4*)(cols + (size_t)(t0 + e4 + q) * INC + 512 + ch) = o;
            }
            asm volatile("" ::: "memory");
        }
    }
}

constexpr int RS = 136;
DI float ret_lg(int hh) { return log2f(1.0f - exp2f(-5.0f - (float)hh)); }
DI void ret_local_unit(const Params& P, LAS unsigned char* lds, int unit) {
    const int tid = otid(), wid = tid >> 6, lane = tid & 63, r = lane & 31, h = lane >> 5;
    const int bl = unit >> 6, hh = (unit >> 4) & 3, seg = unit & 15, rowbase = bl * SEQ + seg * 512;
    const bf16_t* cols = (const bf16_t*)(P.ws + WS_COLS); float* T = (float*)(P.ws + WS_T) + (size_t)unit * 16384;
    LAS bf16_t* Ks = (LAS bf16_t*)lds; LAS bf16_t* Vs = Ks + 64 * RS;
    const float lg = ret_lg(hh);
    const int a = wid >> 1, b0 = (wid & 1) * 2, tg = (lane >> 4) & 1, tq = (lane & 15) >> 2, tp = lane & 3;
    f32x16 acc[2];
#pragma unroll
    for (int i = 0; i < 16; ++i) { acc[0][i] = 0.f; acc[1][i] = 0.f; }
    for (int c = 0; c < 8; ++c) {
        __syncthreads();
#pragma unroll
        for (int e = 0; e < 2; ++e) { const int idx = tid + 512 * e, row = idx >> 4, sg = idx & 15;
            const bf16_t* gp = cols + (size_t)(rowbase + c * 64 + row) * INC + hh * 128 + sg * 8;
            const u32x4 kv = *(const u32x4*)(gp + 2048), vv = *(const u32x4*)(gp + 2560);
            const float sc = exp2f(lg * (float)(511 - (c * 64 + row)));
            u32x4 ks; ks.x = pk2(bflo(kv.x) * sc, bfhi(kv.x) * sc); ks.y = pk2(bflo(kv.y) * sc, bfhi(kv.y) * sc); ks.z = pk2(bflo(kv.z) * sc, bfhi(kv.z) * sc); ks.w = pk2(bflo(kv.w) * sc, bfhi(kv.w) * sc);
            *(LAS u32x4*)(Ks + row * RS + sg * 8) = ks; *(LAS u32x4*)(Vs + row * RS + sg * 8) = vv; }
        __syncthreads();
#pragma unroll
        for (int s = 0; s < 4; ++s) {
            const int tr0 = (16 * s + 8 * h + tq) * RS + 16 * tg + 4 * tp;
            const bf16x8 af = cat8(trd(Ks + tr0 + 32 * a), trd(Ks + tr0 + 4 * RS + 32 * a));
            const bf16x8 bf0 = cat8(trd(Vs + tr0 + 32 * b0), trd(Vs + tr0 + 4 * RS + 32 * b0)), bf1 = cat8(trd(Vs + tr0 + 32 * (b0 + 1)), trd(Vs + tr0 + 4 * RS + 32 * (b0 + 1)));
            acc[0] = MFMA32(af, bf0, acc[0]); acc[1] = MFMA32(af, bf1, acc[1]);
        }
    }
#pragma unroll
    for (int bb = 0; bb < 2; ++bb)
#pragma unroll
        for (int i = 0; i < 16; ++i) T[(size_t)(32 * a + crow(i, h)) * 128 + 32 * (b0 + bb) + r] = acc[bb][i];
}
DI void ret_scan_unit(const Params& P, LAS unsigned char* lds, int unit, int dry = 0) {
    const int tid = otid(), wid = tid >> 6, lane = tid & 63, r = lane & 31, h = lane >> 5;
    const int bl = unit >> 6, hh = (unit >> 4) & 3, seg = unit & 15, rowbase = bl * SEQ + seg * 512;
    bf16_t* cols = (bf16_t*)(P.ws + WS_COLS); const float* T = (const float*)(P.ws + WS_T);
    LAS bf16_t* Qs = (LAS bf16_t*)lds; LAS bf16_t* Ks = Qs + 64 * RS; LAS bf16_t* Kd = Ks + 64 * RS; LAS bf16_t* Vs = Kd + 64 * RS; LAS bf16_t* St = Vs + 64 * RS;
    LAS float* red = (LAS float*)(St + 128 * RS);
    const float lg = ret_lg(hh);
    const int a = wid >> 1, b0 = (wid & 1) * 2, nt = wid >> 2, vt = wid & 3, tg = (lane >> 4) & 1, tq = (lane & 15) >> 2, tp = lane & 3;
    f32x16 Sacc[2];
#pragma unroll
    for (int i = 0; i < 16; ++i) { Sacc[0][i] = 0.f; Sacc[1][i] = 0.f; }
    for (int p = 0; p < seg; ++p) {
        const float f = exp2f(lg * 512.0f * (float)(seg - 1 - p)); const float* Tp = T + (size_t)(unit - seg + p) * 16384;
#pragma unroll
        for (int bb = 0; bb < 2; ++bb)
#pragma unroll
            for (int i = 0; i < 16; ++i) Sacc[bb][i] += f * Tp[(size_t)(32 * a + crow(i, h)) * 128 + 32 * (b0 + bb) + r];
    }
    const float g64 = exp2f(lg * 64.0f);
    u32x4 pq[2], pk[2], pv[2];
#pragma unroll
    for (int e = 0; e < 2; ++e) { const int idx = tid + 512 * e, row = idx >> 4, sg = idx & 15; const bf16_t* gp = cols + (size_t)(rowbase + row) * INC + hh * 128 + sg * 8;
        pq[e] = *(const u32x4*)(gp + 1536); pk[e] = *(const u32x4*)(gp + 2048); pv[e] = *(const u32x4*)(gp + 2560); }
    __syncthreads();
    for (int c = 0; c < 8; ++c) {
#pragma unroll
        for (int bb = 0; bb < 2; ++bb)
#pragma unroll
            for (int g4 = 0; g4 < 4; ++g4) { u32x2 w; w.x = pk2(Sacc[bb][4 * g4], Sacc[bb][4 * g4 + 1]); w.y = pk2(Sacc[bb][4 * g4 + 2], Sacc[bb][4 * g4 + 3]);
                *(LAS u32x2*)(St + (32 * (b0 + bb) + r) * RS + 32 * a + 8 * g4 + 4 * h) = w; }
#pragma unroll
        for (int e = 0; e < 2; ++e) { const int idx = tid + 512 * e, row = idx >> 4, sg = idx & 15;
            const u32x4 qv = pq[e], kv = pk[e], vv = pv[e];
            const float sc = ex2(lg * (float)(63 - row));
            u32x4 ks; ks.x = pk2(bflo(kv.x) * sc, bfhi(kv.x) * sc); ks.y = pk2(bflo(kv.y) * sc, bfhi(kv.y) * sc); ks.z = pk2(bflo(kv.z) * sc, bfhi(kv.z) * sc); ks.w = pk2(bflo(kv.w) * sc, bfhi(kv.w) * sc);
            *(LAS u32x4*)(Qs + row * RS + sg * 8) = qv; *(LAS u32x4*)(Ks + row * RS + sg * 8) = kv; *(LAS u32x4*)(Kd + row * RS + sg * 8) = ks; *(LAS u32x4*)(Vs + row * RS + sg * 8) = vv; }
        __syncthreads();
        if (c + 1 < 8) {
#pragma unroll
            for (int e = 0; e < 2; ++e) { const int idx = tid + 512 * e, row = idx >> 4, sg = idx & 15; const bf16_t* gp = cols + (size_t)(rowbase + (c + 1) * 64 + row) * INC + hh * 128 + sg * 8;
                pq[e] = *(const u32x4*)(gp + 1536); pk[e] = *(const u32x4*)(gp + 2048); pv[e] = *(const u32x4*)(gp + 2560); }
        }
        f32x16 pT[2];
#pragma unroll
        for (int i = 0; i < 16; ++i) { pT[0][i] = 0.f; pT[1][i] = 0.f; }
#pragma unroll
        for (int ks = 0; ks < 8; ++ks) {
            const bf16x8 qf = *(const LAS bf16x8*)(Qs + (32 * nt + r) * RS + 16 * ks + 8 * h);
            const bf16x8 k0 = *(const LAS bf16x8*)(Ks + r * RS + 16 * ks + 8 * h), k1 = *(const LAS bf16x8*)(Ks + (32 + r) * RS + 16 * ks + 8 * h);
            pT[0] = MFMA32(k0, qf, pT[0]); pT[1] = MFMA32(k1, qf, pT[1]);
        }
        const int nq = 32 * nt + r;
#pragma unroll
        for (int mt = 0; mt < 2; ++mt)
#pragma unroll
            for (int i = 0; i < 16; ++i) { const int mm = 32 * mt + crow(i, h); const int dd = nq > mm ? nq - mm : mm - nq; pT[mt][i] *= ex2(lg * (float)dd); }
        f32x16 O1, O2;
#pragma unroll
        for (int i = 0; i < 16; ++i) { O1[i] = 0.f; O2[i] = 0.f; }
#pragma unroll
        for (int mt = 0; mt < 2; ++mt)
#pragma unroll
            for (int s = 0; s < 2; ++s) {
                const bf16x8 af = pack8(pT[mt][8 * s], pT[mt][8 * s + 1], pT[mt][8 * s + 2], pT[mt][8 * s + 3], pT[mt][8 * s + 4], pT[mt][8 * s + 5], pT[mt][8 * s + 6], pT[mt][8 * s + 7]);
                const int tr0 = (32 * mt + 16 * s + 4 * h + tq) * RS + 32 * vt + 16 * tg + 4 * tp;
                const bf16x8 bf = cat8(trd(Vs + tr0), trd(Vs + tr0 + 8 * RS));
                O1 = MFMA32(af, bf, O1);
            }
#pragma unroll
        for (int ks = 0; ks < 8; ++ks) {
            const bf16x8 qf = *(const LAS bf16x8*)(Qs + (32 * nt + r) * RS + 16 * ks + 8 * h);
            const bf16x8 sf = *(const LAS bf16x8*)(St + (32 * vt + r) * RS + 16 * ks + 8 * h);
            O2 = MFMA32(qf, sf, O2);
        }
#pragma unroll
        for (int i = 0; i < 16; ++i) { const int n = 32 * nt + crow(i, h); O1[i] += ex2(lg * (float)(n + 1)) * O2[i]; }
#pragma unroll
        for (int i = 0; i < 16; ++i) { float v = O1[i] * O1[i];
            v += __shfl_xor(v, 1); v += __shfl_xor(v, 2); v += __shfl_xor(v, 4); v += __shfl_xor(v, 8); v += __shfl_xor(v, 16);
            if (r == 0) red[(32 * nt + crow(i, h)) * 4 + vt] = v; }
#pragma unroll
        for (int i = 0; i < 16; ++i) { Sacc[0][i] *= g64; Sacc[1][i] *= g64; }
#pragma unroll
        for (int s = 0; s < 4; ++s) {
            const int tr0 = (16 * s + 8 * h + tq) * RS + 16 * tg + 4 * tp;
            const bf16x8 af = cat8(trd(Kd + tr0 + 32 * a), trd(Kd + tr0 + 4 * RS + 32 * a));
            const bf16x8 bf0 = cat8(trd(Vs + tr0 + 32 * b0), trd(Vs + tr0 + 4 * RS + 32 * b0)), bf1 = cat8(trd(Vs + tr0 + 32 * (b0 + 1)), trd(Vs + tr0 + 4 * RS + 32 * (b0 + 1)));
            Sacc[0] = MFMA32(af, bf0, Sacc[0]); Sacc[1] = MFMA32(af, bf1, Sacc[1]);
        }
        __syncthreads();
#pragma unroll
        for (int i = 0; i < 16; ++i) { const int n = 32 * nt + crow(i, h); const f32x4 q = *(const LAS f32x4*)(red + n * 4);
            const float rn = __builtin_amdgcn_rsqf(((q.x + q.y) + (q.z + q.w)) * (1.f / 128.f) + EPS);
            bf16_t* gp = cols + (size_t)(rowbase + c * 64 + n) * INC + 3072 + hh * 128 + 32 * vt + r;
            const float gv = bf2f(*gp); const bf16_t yv = f2bf(gv * sigm(gv) * O1[i] * rn); if (!dry) *gp = yv; }
        __syncthreads();
    }
}

constexpr int VS = 72;
constexpr int ATT_BIAS_OFF = 0, ATT_SCR_OFF = 8704, ATT_V_OFF = 10240;
DI void attn_bias(f32x16 (&sT)[2], const LAS float* bt, int j, int n, int h) {
    if (j <= 5) { const float b = bt[256];
#pragma unroll
        for (int i = 0; i < 16; ++i) { sT[0][i] += b; sT[1][i] += b; }
    } else {
#pragma unroll
        for (int t = 0; t < 2; ++t)
#pragma unroll
            for (int i = 0; i < 16; ++i) { const int mm = 32 * t + crow(i, h); int dist = 64 * (8 - j) + n - mm; dist = dist > 128 ? 128 : dist; sT[t][i] += bt[dist + 128]; }
    }
}
DI void attn_unit(bf16_t* cols, LAS unsigned char* lds, int wid, int lane, int bl, int hh, int c, int qh, int dry) {
    const int r = lane & 31, h = lane >> 5, tg = (lane >> 4) & 1, tq = (lane & 15) >> 2, tp = lane & 3;
    const LAS float* bt = (const LAS float*)(lds + ATT_BIAS_OFF) + hh * 264;
    LAS float* scr = (LAS float*)(lds + ATT_SCR_OFF) + wid * 32;
    LAS bf16_t* Vs = (LAS bf16_t*)(lds + ATT_V_OFF + wid * (64 * VS * 2));
    const int seqbase = bl * SEQ, tq0 = seqbase + c * 64 + 32 * qh, n = 32 * qh + r;
    bf16x8 qf[4];
#pragma unroll
    for (int d0 = 0; d0 < 4; ++d0) qf[d0] = *(const bf16x8*)(cols + (size_t)(tq0 + r) * INC + 3584 + hh * 64 + 16 * d0 + 8 * h);
    const int j0 = c >= 8 ? 0 : 8 - c;
    bf16x8 kf[2][4]; u32x4 vv[8];
    { const bf16_t* kb = cols + (size_t)(seqbase + (c - 8 + j0) * 64) * INC + 4096 + hh * 64;
#pragma unroll
      for (int t = 0; t < 2; ++t)
#pragma unroll
          for (int d0 = 0; d0 < 4; ++d0) kf[t][d0] = *(const bf16x8*)(kb + (size_t)(32 * t + r) * INC + 16 * d0 + 8 * h);
#pragma unroll
      for (int e = 0; e < 8; ++e) { const int idx = e * 64 + lane; vv[e] = *(const u32x4*)(kb + 512 + (size_t)(idx >> 3) * INC + (idx & 7) * 8); } }
    float mrow = -1e30f, lsum = 0.f;
    f32x16 O[2];
#pragma unroll
    for (int i = 0; i < 16; ++i) { O[0][i] = 0.f; O[1][i] = 0.f; }
    for (int j = j0; j <= 8; ++j) {
        const bf16_t* kbn = cols + (size_t)(seqbase + (c - 7 + j) * 64) * INC + 4096 + hh * 64;
        f32x16 sT[2];
#pragma unroll
        for (int i = 0; i < 16; ++i) { sT[0][i] = 0.f; sT[1][i] = 0.f; }
#pragma unroll
        for (int d0 = 0; d0 < 4; ++d0) { sT[0] = MFMA32(kf[0][d0], qf[d0], sT[0]); sT[1] = MFMA32(kf[1][d0], qf[d0], sT[1]); }
        asm volatile("" ::: "memory");
        if (j < 8) {
#pragma unroll
            for (int t = 0; t < 2; ++t)
#pragma unroll
                for (int d0 = 0; d0 < 4; ++d0) kf[t][d0] = *(const bf16x8*)(kbn + (size_t)(32 * t + r) * INC + 16 * d0 + 8 * h);
        }
        asm volatile("" ::: "memory");
        attn_bias(sT, bt, j, n, h);
        float mx = fmaxf(sT[0][0], sT[1][0]);
#pragma unroll
        for (int i = 1; i < 16; ++i) mx = fmaxf(mx, fmaxf(sT[0][i], sT[1][i]));
        mx = fmaxf(mx, __shfl_xor(mx, 32));
        if (__any(mx > mrow)) {
            const float mnew = fmaxf(mrow, mx), alpha = ex2(mrow - mnew); mrow = mnew; lsum *= alpha;
            if (h == 0) scr[r] = alpha;
            asm volatile("s_waitcnt lgkmcnt(0)" ::: "memory");
#pragma unroll
            for (int g4 = 0; g4 < 4; ++g4) { const f32x4 a4 = *(const LAS f32x4*)(scr + 8 * g4 + 4 * h);
#pragma unroll
                for (int e = 0; e < 4; ++e) { O[0][4 * g4 + e] *= a4[e]; O[1][4 * g4 + e] *= a4[e]; } }
            asm volatile("s_waitcnt lgkmcnt(0)" ::: "memory");
        }
#pragma unroll
        for (int t = 0; t < 2; ++t)
#pragma unroll
            for (int i = 0; i < 16; ++i) { const float p = ex2(sT[t][i] - mrow); sT[t][i] = p; lsum += p; }
#pragma unroll
        for (int e = 0; e < 8; ++e) { const int idx = e * 64 + lane; *(LAS u32x4*)(Vs + (idx >> 3) * VS + (idx & 7) * 8) = vv[e]; }
        asm volatile("s_waitcnt lgkmcnt(0)" ::: "memory");
        if (j < 8) {
#pragma unroll
            for (int e = 0; e < 8; ++e) { const int idx = e * 64 + lane; vv[e] = *(const u32x4*)(kbn + 512 + (size_t)(idx >> 3) * INC + (idx & 7) * 8); }
        }
        asm volatile("" ::: "memory");
#pragma unroll
        for (int t = 0; t < 2; ++t)
#pragma unroll
            for (int s = 0; s < 2; ++s) {
                const bf16x8 af = pack8(sT[t][8 * s], sT[t][8 * s + 1], sT[t][8 * s + 2], sT[t][8 * s + 3], sT[t][8 * s + 4], sT[t][8 * s + 5], sT[t][8 * s + 6], sT[t][8 * s + 7]);
                const int tr0 = (32 * t + 16 * s + 4 * h + tq) * VS + 16 * tg + 4 * tp;
#pragma unroll
                for (int dh = 0; dh < 2; ++dh) { const bf16x8 bf = cat8(trd(Vs + tr0 + 32 * dh), trd(Vs + tr0 + 8 * VS + 32 * dh)); O[dh] = MFMA32(af, bf, O[dh]); }
            }
        asm volatile("s_waitcnt lgkmcnt(0)" ::: "memory");
    }
    lsum += __shfl_xor(lsum, 32);
    if (h == 0) scr[r] = lsum;
    asm volatile("s_waitcnt lgkmcnt(0)" ::: "memory");
#pragma unroll
    for (int i = 0; i < 16; ++i) { const int q = crow(i, h); const float inv = __builtin_amdgcn_rcpf(scr[q]);
        bf16_t* op = cols + (size_t)(tq0 + q) * INC + 3584 + hh * 64 + r;
        const bf16_t o0 = f2bf(O[0][i] * inv), o1 = f2bf(O[1][i] * inv); if (!dry) { op[0] = o0; op[32] = o1; } }
    asm volatile("s_waitcnt lgkmcnt(0)" ::: "memory");
}
DI void attn_phase(const Params& P, LAS unsigned char* lds, int l, int dry = 0) {
    const int tid = otid(), lane = tid & 63, wid = __builtin_amdgcn_readfirstlane(tid >> 6);
    LAS float* bias = (LAS float*)(lds + ATT_BIAS_OFF); const float* rb = P.in[I_RB] + l * 8 * 257;
    __syncthreads();
    for (int i = tid; i < 8 * 257; i += 512) bias[(i / 257) * 264 + (i % 257)] = rb[i] * LOG2E;
    __syncthreads();
    bf16_t* cols = (bf16_t*)(P.ws + WS_COLS);
    for (int u = obid() * 8 + wid; u < 8192; u += gridDim.x * 8) {
        const int qh = u & 1, c = (u >> 1) & 127, hh = (u >> 8) & 7, bl = u >> 11;
        attn_unit(cols, lds, wid, lane, bl, hh, c, qh, dry);
    }
}

DI void final_norm(const Params& P, int dry = 0) {
    const int tid = otid(), lane = tid & 63, wid = tid >> 6; const float* ssq = (const float*)(P.ws + WS_SSQ); const float* w = P.in[I_FN];
    for (int row = obid() * 8 + wid; row < MTOK; row += gridDim.x * 8) {
        const float rs = row_rstd(ssq, row); f32x4* xr = (f32x4*)(P.out + (size_t)row * DM) + lane; const f32x4* wr = (const f32x4*)w + lane;
#pragma unroll
        for (int j = 0; j < 4; ++j) { const f32x4 v = xr[64 * j], g = wr[64 * j]; const f32x4 o = v * rs * g; if (!dry) xr[64 * j] = o; }
    }
}


#define XB_TMO      128
#define XB_XCNT(j)  (256  + 64 * (j))
#define XB_XSUB(j)  (1280 + 64 * (j))
#define XB_XGEN(j)  (2304 + 64 * (j))
#define XB_TOP      3328
#define XB_TOPGEN   3392
#define XB_SPIN_CAP (1u << 22)
DI unsigned xb_ld(unsigned* p)              { return __hip_atomic_load(p, __ATOMIC_RELAXED, __HIP_MEMORY_SCOPE_AGENT); }
DI unsigned xb_add(unsigned* p, unsigned v) { return __hip_atomic_fetch_add(p, v, __ATOMIC_RELAXED, __HIP_MEMORY_SCOPE_AGENT); }
DI unsigned xb_xcc_id() { return (unsigned)__builtin_amdgcn_s_getreg((3 << 11) | 20) & 0xFu; }
#define XB_SPIN(cond, bar) do { unsigned _sp = 0; while (cond) { __builtin_amdgcn_s_sleep(1); \
    if ((++_sp & 255u) == 0u) { if (xb_ld(&(bar)[XB_TMO])) break; if (_sp > XB_SPIN_CAP) { atomicAdd(&(bar)[XB_TMO], 1u); break; } } } } while (0)
struct XcdBarrier { unsigned* bar; unsigned x; volatile LAS unsigned* st; };
DI XcdBarrier xcd_barrier_post(unsigned* bar, volatile LAS unsigned* st) {
    XcdBarrier b; b.bar = bar; b.x = xb_xcc_id(); b.st = st;
    if (threadIdx.x == 0) (void)xb_add(&bar[XB_XCNT(b.x)], 1u);
    return b;
}
DI void xcd_barrier_complete(unsigned* bar, unsigned x, unsigned& nloc, unsigned& nx) {
    const unsigned G = gridDim.x * gridDim.y * gridDim.z;
    unsigned sum, cnt, mine, sp = 0u;
    for (;;) {
        sum = 0u; cnt = 0u; mine = 0u;
#pragma unroll
        for (unsigned j = 0; j < 16; ++j) { const unsigned c = xb_ld(&bar[XB_XCNT(j)]); sum += c; cnt += (c > 0u) ? 1u : 0u; mine = (j == x) ? c : mine; }
        if (sum == G) break;
        __builtin_amdgcn_s_sleep(1);
        if ((++sp & 255u) == 0u) { if (xb_ld(&bar[XB_TMO])) break; if (sp > XB_SPIN_CAP) { atomicAdd(&bar[XB_TMO], 1u); break; } }
    }
    nloc = mine > 0u ? mine : 1u; nx = cnt > 0u ? cnt : 1u;
}
DI void xcd_barrier(const XcdBarrier& b) {
    asm volatile("s_waitcnt vmcnt(0)" ::: "memory");
    __syncthreads();
    if (threadIdx.x == 0) {
        unsigned* bar = b.bar;
        __builtin_amdgcn_s_waitcnt(0);
        unsigned nloc = b.st[0], nx = b.st[1];
        if (nloc == 0u) { xcd_barrier_complete(bar, b.x, nloc, nx); b.st[0] = nloc; b.st[1] = nx; }
        const unsigned old = xb_add(&bar[XB_XSUB(b.x)], 1u);
        const unsigned gen = old / nloc;
        if (old + 1u == (gen + 1u) * nloc) {
            __builtin_amdgcn_fence(__ATOMIC_RELEASE, "agent");
            asm volatile("s_waitcnt vmcnt(0)" ::: "memory");
            const unsigned og = xb_add(&bar[XB_TOP], 1u);
            const unsigned tg = og / nx;
            if (og + 1u == (tg + 1u) * nx) xb_add(&bar[XB_TOPGEN], 1u);
            else XB_SPIN(xb_ld(&bar[XB_TOPGEN]) == tg, bar);
            __builtin_amdgcn_fence(__ATOMIC_ACQUIRE, "agent");
            xb_add(&bar[XB_XGEN(b.x)], 1u);
            asm volatile("s_waitcnt vmcnt(0)" ::: "memory");
        } else {
            XB_SPIN(xb_ld(&bar[XB_XGEN(b.x)]) == gen, bar);
            __builtin_amdgcn_fence(__ATOMIC_ACQUIRE, "agent");
            asm volatile("s_waitcnt vmcnt(0)" ::: "memory");
        }
    }
    __syncthreads();
}

constexpr int NPHASE = 30;
__global__ void __launch_bounds__(512, 2) fwd_kernel(Params Parg) {
    extern __shared__ __attribute__((aligned(16))) unsigned char lds_raw[];
    LAS unsigned char* lds = (LAS unsigned char*)lds_raw;
    const int G = gridDim.x;
    typedef const __attribute__((address_space(4))) Params* KP;
    const KP Pk = (KP)__builtin_amdgcn_kernarg_segment_ptr();
    const int ph_lo = Pk->lo, ph_hi = Pk->hi;
#define XB ((bf16_t*)(ws + WS_XB))
#define COLS ((bf16_t*)(ws + WS_COLS))
#define GB ((bf16_t*)(ws + WS_G))
#define HID ((bf16_t*)(ws + WS_HID))
#define SSQ ((float*)(ws + WS_SSQ))
    volatile LAS unsigned* MISC = (volatile LAS unsigned*)(lds + 131072 + 64);
    if (threadIdx.x < 4) MISC[threadIdx.x] = 0u;
    __syncthreads();
    XcdBarrier bar; bar.bar = (unsigned*)(Pk->ws + WS_BAR); bar.x = 0; bar.st = MISC;
    for (int ph = ph_lo; ph < ph_hi; ++ph) {
        if (ph > ph_lo) {
            if (ph == ph_lo + 1) { cg::this_grid().sync(); bar = xcd_barrier_post((unsigned*)(Pk->ws + WS_BAR), MISC); }
            else xcd_barrier(bar);
        }
        KP Pp = Pk; asm volatile("" : "+s"(Pp));
        const Params& P = *(const Params*)Pp;
        unsigned char* ws = P.ws;
        if (ph == 0) { prologue(P, lds); if (PROBE == 3) prologue(P, lds); continue; }
        if (ph == NPHASE - 1) { if (PROBE == 3) final_norm(P, P.hi != 12345); final_norm(P); continue; }
        const int l = (ph - 1) / 14, k = (ph - 1) % 14;
        unsigned char* wl = ws + WS_WT + (size_t)l * WLAYER;
        pg8::StaticOrder S;
        if (k == 0 || k == 12) {
            pg8::Gemm g{XB, (const bf16_t*)(wl + (k == 0 ? WO1 : WO6)), DM, XLD}; S.init(MTOK, 2 * DFF, G, obid());
            pg8::EpiGateUp E{HID, SSQ}; for (int rep = 0; rep < (PROBE == 2 ? 2 : 1); ++rep) pg8::gemm_phase<pg8::EpiGateUp>(lds, g, S, E);
        } else if (k == 1 || k == 13) {
            pg8::Gemm g{HID, (const bf16_t*)(wl + (k == 1 ? WO2 : WO7)), DFF, DFF}; S.init(MTOK, DM, G, obid());
            pg8::EpiResid E{(l == 0 && k == 1) ? P.in[I_X] : (const float*)nullptr, (l == 1 && k == 13) ? P.out : (float*)nullptr, XB, SSQ, 0.5f, 0, 0};
#if PROBE == 4
            { pg8::EpiResid Ed = E; Ed.dry = (P.hi != 12345); pg8::gemm_phase<pg8::EpiResid>(lds, g, S, Ed); }
#endif
            pg8::gemm_phase<pg8::EpiResid>(lds, g, S, E);
        } else {
            const int half = (k - 2) / 5, kk = (k - 2) % 5, row0 = half * HROWS;
            if (kk == 0) {
                pg8::Gemm g{XB + (size_t)row0 * XLD, (const bf16_t*)(wl + WO3), DM, XLD}; S.init(HROWS, NCAT, G, obid());
                pg8::EpiInProj E{COLS, GB, SSQ, (const float*)(ws + WS_COS), (const float*)(ws + WS_SIN), row0}; for (int rep = 0; rep < (PROBE == 2 ? 2 : 1); ++rep) pg8::gemm_phase<pg8::EpiInProj>(lds, g, S, E);
            } else if (kk == 1) {
#if PROBE == 1
                if (P.hi != 12345) { for (int u = obid(); u < 256; u += G) ret_local_unit(P, lds, u); conv_phase(P, l, P.hi != 12345); }
#endif
                if (HAS(4)) { for (int u = obid(); u < 256; u += G) ret_local_unit(P, lds, u);
                conv_phase(P, l); }
            } else if (kk == 2) {
#if PROBE == 1
                if (P.hi != 12345) { for (int u = obid(); u < 256; u += G) ret_scan_unit(P, lds, u, P.hi != 12345); attn_phase(P, lds, l, P.hi != 12345); }
#endif
#if PROBE == 6
                if (P.hi != 12345) attn_phase(P, lds, l, P.hi != 12345);
#endif
#if PROBE == 7
                if (P.hi != 12345) { for (int u = obid(); u < 256; u += G) ret_scan_unit(P, lds, u, P.hi != 12345); }
#endif
                if (HAS(5)) for (int u = obid(); u < 256; u += G) ret_scan_unit(P, lds, u);
                if (HAS(6)) attn_phase(P, lds, l);
            } else if (kk == 3) {
                pg8::Gemm g{COLS, (const bf16_t*)(wl + WO4), 512, INC}; S.init(HROWS, DM, G, obid(), 1);
                pg8::EpiBranch E{GB, (bf16_t*)(ws + WS_MB), 0};
                pg8::gemm_phase<pg8::EpiBranch, true>(lds, g, S, E);
            } else {
                pg8::Gemm g{(const bf16_t*)(ws + WS_MB), (const bf16_t*)(wl + WO5), DM, XLD}; S.init(HROWS, DM, G, obid());
                pg8::EpiResid E{nullptr, nullptr, XB, SSQ, 1.0f, row0, 0};
#if PROBE == 4
                { pg8::EpiResid Ed = E; Ed.dry = (P.hi != 12345); pg8::gemm_phase<pg8::EpiResid>(lds, g, S, Ed); }
#endif
                pg8::gemm_phase<pg8::EpiResid>(lds, g, S, E);
            }
        }
    }
}

extern "C" void kernel_launch(void* const* d_in, const int* in_sizes, int n_in, void* d_out, int out_size, void* d_ws, size_t ws_size, hipStream_t stream) {
    static int grid = 0;
    if (grid == 0) {
        if (n_in != 17 || out_size != MTOK * DM || ws_size < WS_END) { fprintf(stderr, "kernel_launch: unexpected shapes (n_in %d out %d ws %zu)\n", n_in, out_size, ws_size); grid = -1; return; }
        int dev = 0, cus = 0, per_cu = 0;
        (void)hipGetDevice(&dev); (void)hipDeviceGetAttribute(&cus, hipDeviceAttributeMultiprocessorCount, dev);
        (void)hipFuncSetAttribute((const void*)fwd_kernel, hipFuncAttributeMaxDynamicSharedMemorySize, LDS_BYTES);
        if (hipOccupancyMaxActiveBlocksPerMultiprocessor(&per_cu, (const void*)fwd_kernel, 512, LDS_BYTES) != hipSuccess || per_cu < 1) per_cu = 1;
        (void)hipGetLastError();
        if (cus <= 0) cus = 256;
        grid = cus * per_cu;
    }
    if (grid < 0) return;
    Params p{};
    for (int i = 0; i < 17; ++i) p.in[i] = (const float*)d_in[i];
    p.out = (float*)d_out; p.ws = (unsigned char*)d_ws;
    for (int i = 0; i < 64; ++i) p.invf[i] = powf(10000.0f, -((float)i / 63.0f));
#if MK_MULTI
    for (int ph = 0; ph < NPHASE; ++ph) { p.lo = ph; p.hi = ph + 1; hipLaunchKernelGGL(fwd_kernel, dim3(grid), dim3(512), LDS_BYTES, stream, p); }
#else
    p.lo = 0; p.hi = NPHASE;
    void* args[] = {&p};
    hipError_t e = hipLaunchCooperativeKernel((const void*)fwd_kernel, dim3(grid), dim3(512), args, LDS_BYTES, stream);
    if (e != hipSuccess) fprintf(stderr, "cooperative launch failed: %s (grid %d)\n", hipGetErrorString(e), grid);
#endif
}
```

```cpp
#include <hip/hip_runtime.h>
#include <hip/hip_cooperative_groups.h>
#include <cstdio>
#include <cstdint>
#include <cmath>
namespace cg = cooperative_groups;

#ifndef MK_MULTI
#define MK_MULTI 0
#endif

#ifndef PROBE
#define PROBE 0
#endif
#ifndef PH_MASK
#define PH_MASK 0x1ff
#endif
#define HAS(x) (((PH_MASK) >> (x)) & 1)
#define DI __device__ __forceinline__
#define LAS __attribute__((address_space(3)))
typedef unsigned short bf16_t;
typedef short bf16x8 __attribute__((ext_vector_type(8)));
typedef float f32x4 __attribute__((ext_vector_type(4)));
typedef float f32x16 __attribute__((ext_vector_type(16)));
typedef unsigned u32x4 __attribute__((ext_vector_type(4)));
typedef unsigned u32x2 __attribute__((ext_vector_type(2)));
typedef float f32x2_t __attribute__((ext_vector_type(2)));
typedef __bf16 bf16x2_t __attribute__((ext_vector_type(2)));

constexpr int DM = 1024, SEQ = 8192, NBATCH = 8, MTOK = NBATCH * SEQ, DFF = 2816, INC = 5120, GZ = 3072, NCAT = INC + GZ;
constexpr int HROWS = MTOK / 2;
constexpr float EPS = 1e-6f;
constexpr float LOG2E = 1.4426950408889634f;
constexpr size_t MiB = (size_t)1 << 20;
constexpr size_t WS_BAR = 0;
constexpr size_t WS_SSQ = 1 * MiB;
constexpr size_t WS_COS = 5 * MiB, WS_SIN = 7 * MiB;
constexpr size_t WS_T = 9 * MiB;
constexpr size_t WS_WT = 26 * MiB;
constexpr size_t WO1 = 0, WO2 = WO1 + (size_t)2 * DFF * DM * 2, WO3 = WO2 + (size_t)DM * DFF * 2, WO4 = WO3 + (size_t)NCAT * DM * 2,
                 WO5 = WO4 + (size_t)GZ * 512 * 2, WO6 = WO5 + (size_t)DM * DM * 2, WO7 = WO6 + (size_t)2 * DFF * DM * 2, WLAYER = WO7 + (size_t)DM * DFF * 2;
constexpr size_t WS_XB = 144 * MiB;
constexpr size_t WS_COLS = 272 * MiB;
constexpr size_t WS_G = 592 * MiB;
constexpr size_t WS_HID = 272 * MiB;
constexpr size_t WS_MB = 784 * MiB;
constexpr size_t WS_END = 848 * MiB;
static_assert(WS_WT + 2 * WLAYER <= WS_XB && WS_HID + (size_t)MTOK * DFF * 2 <= WS_END && WS_COLS + (size_t)HROWS * INC * 2 <= WS_G, "ws map");
#define XCD_BAR_WORDS 3456
constexpr int LDS_BYTES = 147456;

DI int otid() { int t = threadIdx.x; asm volatile("" : "+v"(t)); return t; }
DI int obid() { int b = blockIdx.x; asm volatile("" : "+s"(b)); return b; }
DI unsigned pk2(float lo, float hi) { f32x2_t v = {lo, hi}; bf16x2_t b = __builtin_convertvector(v, bf16x2_t); return __builtin_bit_cast(unsigned, b); }
DI float bflo(unsigned w) { return __uint_as_float(w << 16); }
DI float bfhi(unsigned w) { return __uint_as_float(w & 0xffff0000u); }
DI float bf2f(bf16_t u) { return __uint_as_float(((unsigned)u) << 16); }
DI bf16_t f2bf(float f) { return (bf16_t)(pk2(f, 0.f) & 0xffffu); }
DI float ex2(float x) { return __builtin_amdgcn_exp2f(x); }
DI float sigm(float v) { return __builtin_amdgcn_rcpf(1.f + ex2(-LOG2E * v)); }
DI int crow(int reg, int h) { return (reg & 3) + 8 * (reg >> 2) + 4 * h; }
#define MFMA32(a, b, c) __builtin_amdgcn_mfma_f32_32x32x16_bf16((a), (b), (c), 0, 0, 0)
DI bf16x8 pack8(float a0, float a1, float a2, float a3, float a4, float a5, float a6, float a7) {
    u32x4 p; p.x = pk2(a0, a1); p.y = pk2(a2, a3); p.z = pk2(a4, a5); p.w = pk2(a6, a7); return __builtin_bit_cast(bf16x8, p);
}
typedef short v4i16_t __attribute__((ext_vector_type(4)));
DI v4i16_t trd(const LAS bf16_t* p) { return __builtin_amdgcn_ds_read_tr16_b64_v4i16((LAS v4i16_t*)p); }
DI bf16x8 cat8(v4i16_t lo, v4i16_t hi) { return __builtin_shufflevector(lo, hi, 0, 1, 2, 3, 4, 5, 6, 7); }
#ifndef NT_STORE
#define NT_STORE 1
#endif
DI void st16(void* p, u32x4 v) {
#if NT_STORE
    __builtin_nontemporal_store(v, (u32x4*)p);
#else
    *(u32x4*)p = v;
#endif
}
DI float row_rstd(const float* ssq, int grow) {
    const f32x4* p = (const f32x4*)(ssq + (size_t)grow * 16); const f32x4 a = p[0], b = p[1], c = p[2], d = p[3];
    const float s = ((a.x + a.y) + (a.z + a.w)) + ((b.x + b.y) + (b.z + b.w)) + ((c.x + c.y) + (c.z + c.w)) + ((d.x + d.y) + (d.z + d.w));
    return __builtin_amdgcn_rsqf(s * (1.f / DM) + EPS);
}

namespace pg8 {
constexpr int BM = 256, BK = 64, HALF = 128, HTB = HALF * BK * 2, STAGE_BYTES = 8 * HTB, NXCD = 8, WGM = 8;
__host__ __device__ __forceinline__ int lds_byte(int r, int c) { const int st = (r >> 4) * 2 + (c >> 5), rr = r & 15, cc = c & 31, ob = rr * 64 + cc * 2; return st * 1024 + (ob ^ (((ob >> 9) & 1) << 5)); }
__host__ __device__ __forceinline__ void stage_rc(int b, int& R, int& C) { const int st = b / 1024, sb = b % 1024, swz = sb ^ (((sb >> 9) & 1) << 5); R = (st >> 1) * 16 + swz / 64; C = (st & 1) * 32 + (swz % 64) / 2; }
__host__ __device__ __forceinline__ int perm32(int rho) { const int n = rho >> 4, i = rho & 15; return 8 * (i >> 2) + 4 * n + (i & 3); }
struct Unit { int pm, pn; };
struct Gemm { const bf16_t* A; const bf16_t* Bt; int K, lda; };
struct StaticOrder {
    int nM, nN, nwg, G, c;
    __device__ void init(int M, int N, int G_, int c_, int br3_ = 0) { nM = M / BM; nN = N / BM; nwg = nM * nN; G = G_; c = c_; br3 = br3_; }
    int br3;
    __device__ bool next(int i, Unit& u) const {
        if (br3) { const int b = i % 3; if (!next1(i / 3, u)) return false; u.pn += b * nN; return true; }
        return next1(i, u);
    }
    __device__ bool next1(int i, Unit& u) const {
        const long L = (long)i * G + c; if (L >= nwg) return false;
        int wgid = (int)L; { const int q = nwg / NXCD, r = nwg % NXCD, xcd = wgid % NXCD, off = wgid / NXCD; wgid = (xcd < r ? xcd * (q + 1) : r * (q + 1) + (xcd - r) * q) + off; }
        const int nig = WGM * nN, gid = wgid / nig, fm = gid * WGM, gsz = (nM - fm) < WGM ? (nM - fm) : WGM;
        u.pm = fm + ((wgid % nig) % gsz); u.pn = (wgid % nig) / gsz; return true;
    }
};
template <class Epi, bool BR = false>
DI void gemm_phase(LAS unsigned char* lds, const Gemm g, const StaticOrder& S, const Epi& E) {
    const int tid = otid(), wid = __builtin_amdgcn_readfirstlane(tid >> 6), lane = tid & 63, wr = wid >> 2, wc = wid & 3, fr = lane & 15, fq = lane >> 4;
    const int K = g.K, nt = K / BK, lda = g.lda;
    unsigned voffA[2], voffB[2];
#pragma unroll
    for (int i = 0; i < 2; ++i) { int R, C; stage_rc(tid * 16 + i * 8192, R, C); const int Rb = (R & ~31) + perm32(R & 31);
        voffA[i] = (unsigned)(R * lda + C) * 2u; voffB[i] = (unsigned)(Rb * K + C) * 2u; }
    const size_t kstep = (size_t)(BK * 2);
    const size_t hA = (size_t)HALF * lda * 2, tA = 2 * hA;
    const size_t hB = (size_t)HALF * K * 2, tB = 2 * hB;
    const unsigned ldsw = (unsigned)wid * 1024u;
    const int aoff = lds_byte(wr * 64 + fr, fq * 8), boff = lds_byte(wc * 32 + fr, fq * 8);
#define PG8_SA(b, h) (((b) * 2 + (h)) * HTB)
#define PG8_SB(b, h) ((4 + (b) * 2 + (h)) * HTB)
#define PG8_STAGE(bufoff, gbase, voff) do { _Pragma("unroll") for (int _i = 0; _i < 2; ++_i) \
        __builtin_amdgcn_global_load_lds((const unsigned*)((const char*)(gbase) + (voff)[_i]), (LAS unsigned*)(lds + (bufoff) + ldsw + _i * 8192), 16, 0, 0); } while (0)
#define PG8_LDA(dst, b, h) do { _Pragma("unroll") for (int m = 0; m < 4; ++m) _Pragma("unroll") for (int k = 0; k < 2; ++k) dst[m][k] = *(const LAS bf16x8*)(lds + PG8_SA(b, h) + aoff + m * 2048 + k * 1024); } while (0)
#define PG8_LDB(dst, b, h) do { _Pragma("unroll") for (int n = 0; n < 2; ++n) _Pragma("unroll") for (int k = 0; k < 2; ++k) dst[n][k] = *(const LAS bf16x8*)(lds + PG8_SB(b, h) + boff + n * 2048 + k * 1024); } while (0)
#define PG8_MMA(ai, bj, At, Bt) do { __builtin_amdgcn_s_setprio(1); _Pragma("unroll") for (int m = 0; m < 4; ++m) _Pragma("unroll") for (int n = 0; n < 2; ++n) _Pragma("unroll") for (int k = 0; k < 2; ++k) \
        acc[ai][bj][m][n] = __builtin_amdgcn_mfma_f32_16x16x32_bf16(Bt[n][k], At[m][k], acc[ai][bj][m][n], 0, 0, 0); __builtin_amdgcn_s_setprio(0); } while (0)
#define PG8_WAIT_V(n) asm volatile("s_waitcnt vmcnt(" #n ")" ::: "memory")
#define PG8_WAIT_L(n) asm volatile("s_waitcnt lgkmcnt(" #n ")" ::: "memory")
#define PG8_BAR __builtin_amdgcn_s_barrier()
#define PG8_SCHED __builtin_amdgcn_sched_barrier(0)
#define PG8_ACOL(u) (BR ? (((u).pn >> 2) == 0 ? 512 : (((u).pn >> 2) == 1 ? 3072 : 3584)) : 0)
    Unit cur, nxt; int ui = 0;
    if (!S.next(0, cur)) return;
    f32x4 acc[2][2][4][2];
#pragma unroll
    for (int a = 0; a < 2; ++a)
#pragma unroll
        for (int b = 0; b < 2; ++b)
#pragma unroll
            for (int m = 0; m < 4; ++m)
#pragma unroll
                for (int n = 0; n < 2; ++n) acc[a][b][m][n] = (f32x4){0.f, 0.f, 0.f, 0.f};
    bf16x8 At[4][2], B0[2][2], B1[2][2];
    const char* cA = (const char*)g.A + (size_t)cur.pm * tA + (size_t)PG8_ACOL(cur) * 2; const char* cB = (const char*)g.Bt + (size_t)cur.pn * tB;
    PG8_STAGE(PG8_SB(0, 0), cB, voffB); PG8_STAGE(PG8_SB(0, 1), cB + hB, voffB); PG8_STAGE(PG8_SA(0, 0), cA, voffA); PG8_STAGE(PG8_SA(0, 1), cA + hA, voffA);
    if (wr == 1) PG8_BAR;
    PG8_WAIT_V(2); PG8_BAR;
    PG8_STAGE(PG8_SB(1, 0), cB + kstep, voffB); PG8_STAGE(PG8_SA(1, 0), cA + kstep, voffA); PG8_STAGE(PG8_SB(1, 1), cB + hB + kstep, voffB);
    PG8_WAIT_V(6); PG8_BAR;
    for (;;) {
        const bool has_next = S.next(ui + 1, nxt);
        const char* nA = has_next ? (const char*)g.A + (size_t)nxt.pm * tA + (size_t)PG8_ACOL(nxt) * 2 : cA; const char* nB = has_next ? (const char*)g.Bt + (size_t)nxt.pn * tB : cB;
        for (int t = 0; t < nt; t += 2) {
            const bool last = (t == nt - 2);
            const char* a1 = cA + (size_t)(t + 1) * kstep;
            const char* a2 = last ? nA : cA + (size_t)(t + 2) * kstep; const char* b2 = last ? nB : cB + (size_t)(t + 2) * kstep;
            const char* a3 = a2 + kstep; const char* b3 = b2 + kstep;
            PG8_LDB(B0, 0, 0); PG8_LDB(B1, 0, 1); PG8_SCHED; PG8_LDA(At, 0, 0); PG8_STAGE(PG8_SA(1, 1), a1 + hA, voffA);
            PG8_WAIT_V(8); PG8_WAIT_L(0); PG8_BAR; PG8_MMA(0, 0, At, B0); PG8_MMA(0, 1, At, B1); PG8_BAR; PG8_SCHED;
            PG8_LDA(At, 0, 1); PG8_STAGE(PG8_SB(0, 0), b2, voffB); PG8_STAGE(PG8_SB(0, 1), b2 + hB, voffB); PG8_STAGE(PG8_SA(0, 0), a2, voffA);
            PG8_WAIT_V(8); PG8_WAIT_L(0); PG8_BAR; PG8_MMA(1, 0, At, B0); PG8_MMA(1, 1, At, B1); PG8_BAR; PG8_SCHED;
            PG8_LDB(B0, 1, 0); PG8_LDB(B1, 1, 1); PG8_SCHED; PG8_LDA(At, 1, 0); PG8_STAGE(PG8_SA(0, 1), a2 + hA, voffA);
            PG8_WAIT_V(8); PG8_WAIT_L(0); PG8_BAR; PG8_MMA(0, 0, At, B0); PG8_MMA(0, 1, At, B1); PG8_BAR; PG8_SCHED;
            PG8_LDA(At, 1, 1); PG8_STAGE(PG8_SB(1, 0), b3, voffB); PG8_STAGE(PG8_SB(1, 1), b3 + hB, voffB); PG8_STAGE(PG8_SA(1, 0), a3, voffA);
            PG8_WAIT_V(8); PG8_WAIT_L(0); PG8_BAR; PG8_MMA(1, 0, At, B0); PG8_MMA(1, 1, At, B1); PG8_BAR; PG8_SCHED;
        }
        if (wr == 0) PG8_BAR;
        E(acc, cur, wr, wc, fr, fq);
        if (!has_next) break;
#pragma unroll
        for (int a = 0; a < 2; ++a)
#pragma unroll
            for (int b = 0; b < 2; ++b)
#pragma unroll
                for (int m = 0; m < 4; ++m)
#pragma unroll
                    for (int n = 0; n < 2; ++n) acc[a][b][m][n] = (f32x4){0.f, 0.f, 0.f, 0.f};
        cur = nxt; cA = nA; cB = nB; ++ui;
        if (wr == 1) PG8_BAR;
    }
    PG8_WAIT_V(0);
    PG8_BAR;
#undef PG8_SA
#undef PG8_SB
#undef PG8_STAGE
#undef PG8_LDA
#undef PG8_LDB
#undef PG8_MMA
#undef PG8_WAIT_V
#undef PG8_WAIT_L
#undef PG8_BAR
#undef PG8_SCHED
#undef PG8_ACOL
}

struct EpiGateUp {
    bf16_t* H; const float* ssq; int dry;
    DI void operator()(const f32x4 (&acc)[2][2][4][2], const Unit& u, int wr, int wc, int fr, int fq) const {
        const int lane = fr + 16 * fq;
        const float rs0 = row_rstd(ssq, u.pm * BM + wr * 64 + lane), rs1 = row_rstd(ssq, u.pm * BM + HALF + wr * 64 + lane);
        asm volatile("" ::: "memory");
#pragma unroll
        for (int ai = 0; ai < 2; ++ai)
#pragma unroll
            for (int m = 0; m < 4; ++m) {
                const int r = u.pm * BM + ai * HALF + wr * 64 + m * 16 + fr; const float rs = __shfl(ai ? rs1 : rs0, m * 16 + fr);
                float hv[8];
#pragma unroll
                for (int n = 0; n < 2; ++n)
#pragma unroll
                    for (int j = 0; j < 4; ++j) { const float gt = acc[ai][0][m][n][j] * rs, up = acc[ai][1][m][n][j] * rs; hv[4 * n + j] = gt * sigm(gt) * up; }
                u32x4 w; w.x = pk2(hv[0], hv[1]); w.y = pk2(hv[2], hv[3]); w.z = pk2(hv[4], hv[5]); w.w = pk2(hv[6], hv[7]);
                if (!dry) st16(H + (size_t)r * DFF + u.pn * 128 + wc * 32 + 8 * fq, w);
            }
    }
};
struct EpiResid {
    const float* xin32; float* xout32; bf16_t* xb; float* ssq; float alpha; int row0; int dry; bf16_t* xbo; float* ssqo;
    DI void operator()(const f32x4 (&acc)[2][2][4][2], const Unit& u, int wr, int wc, int fr, int fq) const {
#pragma unroll
        for (int ai = 0; ai < 2; ++ai) {
            f32x4 v[4][2][2];
            if (xin32) {
#pragma unroll
                for (int m = 0; m < 4; ++m)
#pragma unroll
                    for (int bj = 0; bj < 2; ++bj) { const size_t off = (size_t)(row0 + u.pm * BM + ai * HALF + wr * 64 + m * 16 + fr) * DM + u.pn * BM + bj * HALF + wc * 32 + 8 * fq;
                        v[m][bj][0] = *(const f32x4*)(xin32 + off); v[m][bj][1] = *(const f32x4*)(xin32 + off + 4); }
            } else {
                u32x4 xv[4][2];
#pragma unroll
                for (int m = 0; m < 4; ++m)
#pragma unroll
                    for (int bj = 0; bj < 2; ++bj) xv[m][bj] = *(const u32x4*)(xb + (size_t)(row0 + u.pm * BM + ai * HALF + wr * 64 + m * 16 + fr) * DM + u.pn * BM + bj * HALF + wc * 32 + 8 * fq);
#pragma unroll
                for (int m = 0; m < 4; ++m)
#pragma unroll
                    for (int bj = 0; bj < 2; ++bj) { const u32x4 t = xv[m][bj]; v[m][bj][0] = (f32x4){bflo(t.x), bfhi(t.x), bflo(t.y), bfhi(t.y)}; v[m][bj][1] = (f32x4){bflo(t.z), bfhi(t.z), bflo(t.w), bfhi(t.w)}; }
            }
            asm volatile("" ::: "memory");
#pragma unroll
            for (int m = 0; m < 4; ++m) {
                const int r = row0 + u.pm * BM + ai * HALF + wr * 64 + m * 16 + fr; float sq = 0.f;
#pragma unroll
                for (int bj = 0; bj < 2; ++bj) {
                    const size_t off = (size_t)r * DM + u.pn * BM + bj * HALF + wc * 32 + 8 * fq;
                    const f32x4 v0 = v[m][bj][0] + acc[ai][bj][m][0] * alpha, v1 = v[m][bj][1] + acc[ai][bj][m][1] * alpha;
                    if (!dry) {
                        if (xout32) { *(f32x4*)(xout32 + off) = v0; *(f32x4*)(xout32 + off + 4) = v1; }
                        else { u32x4 w; w.x = pk2(v0[0], v0[1]); w.y = pk2(v0[2], v0[3]); w.z = pk2(v1[0], v1[1]); w.w = pk2(v1[2], v1[3]); *(u32x4*)(xbo + off) = w; }
                    }
                    sq += (v0[0] * v0[0] + v0[1] * v0[1]) + (v0[2] * v0[2] + v0[3] * v0[3]) + (v1[0] * v1[0] + v1[1] * v1[1]) + (v1[2] * v1[2] + v1[3] * v1[3]);
                }
                sq += __shfl_xor(sq, 16); sq += __shfl_xor(sq, 32);
                if (fq == 0 && !dry) ssqo[(size_t)r * 16 + u.pn * 4 + wc] = sq;
            }
            asm volatile("" ::: "memory");
        }
    }
};
struct EpiInProj {
    bf16_t* cols; bf16_t* G; const float* ssq; const float* cosT; const float* sinT; int row0; int dry;
    DI void operator()(const f32x4 (&acc)[2][2][4][2], const Unit& u, int wr, int wc, int fr, int fq) const {
        const int pn = u.pn, lane = fr + 16 * fq;
        const float rs0 = row_rstd(ssq, row0 + u.pm * BM + wr * 64 + lane), rs1 = row_rstd(ssq, row0 + u.pm * BM + HALF + wr * 64 + lane);
        asm volatile("" ::: "memory");
#pragma unroll
        for (int ai = 0; ai < 2; ++ai)
#pragma unroll
            for (int m = 0; m < 4; ++m) {
                const int rl = u.pm * BM + ai * HALF + wr * 64 + m * 16 + fr; const float rs = __shfl(ai ? rs1 : rs0, m * 16 + fr);
                if (pn >= 20) {
#pragma unroll
                    for (int bj = 0; bj < 2; ++bj) { const f32x4 a0 = acc[ai][bj][m][0] * rs, a1 = acc[ai][bj][m][1] * rs;
                        u32x4 w; w.x = pk2(sigm(a0[0]), sigm(a0[1])); w.y = pk2(sigm(a0[2]), sigm(a0[3])); w.z = pk2(sigm(a1[0]), sigm(a1[1])); w.w = pk2(sigm(a1[2]), sigm(a1[3]));
                        if (!dry) st16(G + (size_t)rl * GZ + (pn - 20) * BM + bj * HALF + wc * 32 + 8 * fq, w); }
                } else if (pn >= 6 && pn < 10) {
                    const int pos = (row0 + rl) & (SEQ - 1), hh = wc >> 1, dd0 = 32 * (wc & 1) + 8 * fq;
                    const f32x4 c0 = *(const f32x4*)(cosT + pos * 64 + dd0), c1 = *(const f32x4*)(cosT + pos * 64 + dd0 + 4);
                    const f32x4 s0 = *(const f32x4*)(sinT + pos * 64 + dd0), s1 = *(const f32x4*)(sinT + pos * 64 + dd0 + 4);
                    const f32x4 x10 = acc[ai][0][m][0] * rs, x11 = acc[ai][0][m][1] * rs, x20 = acc[ai][1][m][0] * rs, x21 = acc[ai][1][m][1] * rs;
                    const f32x4 y10 = x10 * c0 - x20 * s0, y11 = x11 * c1 - x21 * s1, y20 = x10 * s0 + x20 * c0, y21 = x11 * s1 + x21 * c1;
                    u32x4 w1, w2; w1.x = pk2(y10[0], y10[1]); w1.y = pk2(y10[2], y10[3]); w1.z = pk2(y11[0], y11[1]); w1.w = pk2(y11[2], y11[3]);
                    w2.x = pk2(y20[0], y20[1]); w2.y = pk2(y20[2], y20[3]); w2.z = pk2(y21[0], y21[1]); w2.w = pk2(y21[2], y21[3]);
                    bf16_t* p = cols + (size_t)rl * INC + pn * BM + hh * 128 + dd0;
                    if (!dry) { st16(p, w1); st16(p + 64, w2); }
                } else {
#pragma unroll
                    for (int bj = 0; bj < 2; ++bj) { const f32x4 a0 = acc[ai][bj][m][0] * rs, a1 = acc[ai][bj][m][1] * rs;
                        u32x4 w; w.x = pk2(a0[0], a0[1]); w.y = pk2(a0[2], a0[3]); w.z = pk2(a1[0], a1[1]); w.w = pk2(a1[2], a1[3]);
                        if (!dry) st16(cols + (size_t)rl * INC + pn * BM + bj * HALF + wc * 32 + 8 * fq, w); }
                }
            }
    }
};
struct EpiBranch {
    const bf16_t* Gt; bf16_t* Mb; int dry;
    DI void operator()(const f32x4 (&acc)[2][2][4][2], const Unit& u, int wr, int wc, int fr, int fq) const {
        const int br = u.pn >> 2, pc = u.pn & 3;
#pragma unroll
        for (int ai = 0; ai < 2; ++ai) {
            u32x4 gv[4][2], mv[4][2];
#pragma unroll
            for (int m = 0; m < 4; ++m)
#pragma unroll
                for (int bj = 0; bj < 2; ++bj) { const int rl = u.pm * BM + ai * HALF + wr * 64 + m * 16 + fr;
                    gv[m][bj] = *(const u32x4*)(Gt + (size_t)rl * GZ + u.pn * BM + bj * HALF + wc * 32 + 8 * fq);
                    if (br) mv[m][bj] = *(const u32x4*)(Mb + (size_t)rl * DM + pc * BM + bj * HALF + wc * 32 + 8 * fq); else mv[m][bj] = (u32x4){0u, 0u, 0u, 0u}; }
            asm volatile("" ::: "memory");
#pragma unroll
            for (int m = 0; m < 4; ++m)
#pragma unroll
                for (int bj = 0; bj < 2; ++bj) {
                    const int rl = u.pm * BM + ai * HALF + wr * 64 + m * 16 + fr; const u32x4 g = gv[m][bj], mm = mv[m][bj];
                    const f32x4 a0 = acc[ai][bj][m][0], a1 = acc[ai][bj][m][1];
                    u32x4 w; w.x = pk2(bflo(mm.x) + bflo(g.x) * a0[0], bfhi(mm.x) + bfhi(g.x) * a0[1]); w.y = pk2(bflo(mm.y) + bflo(g.y) * a0[2], bfhi(mm.y) + bfhi(g.y) * a0[3]);
                    w.z = pk2(bflo(mm.z) + bflo(g.z) * a1[0], bfhi(mm.z) + bfhi(g.z) * a1[1]); w.w = pk2(bflo(mm.w) + bflo(g.w) * a1[2], bfhi(mm.w) + bfhi(g.w) * a1[3]);
                    if (!dry) *(u32x4*)(Mb + (size_t)rl * DM + pc * BM + bj * HALF + wc * 32 + 8 * fq) = w;
                }
            asm volatile("" ::: "memory");
        }
    }
};
}

struct Params { const float* in[17]; float* out; unsigned char* ws; int lo, hi; float invf[64]; };
enum { I_X = 0, I_F1N, I_F1G, I_F1U, I_F1D, I_MN, I_WIN, I_CW, I_RB, I_WB, I_WMG, I_WO, I_F2N, I_F2G, I_F2U, I_F2D, I_FN };

struct WJob { const float* src; int ld, K, N; const float* gain; bf16_t* dst; int Kdst, koff, mode, rowoff; };
DI WJob get_job(const Params& P, int l, int j) {
    WJob w; unsigned char* wl = P.ws + WS_WT + (size_t)l * WLAYER;
    w.gain = nullptr; w.koff = 0; w.mode = 0; w.rowoff = 0;
    if (j == 0 || j == 1 || j == 11 || j == 12) {
        const bool second = j >= 11; const bool up = (j == 1 || j == 12);
        w.src = P.in[second ? (up ? I_F2U : I_F2G) : (up ? I_F1U : I_F1G)] + (size_t)l * DM * DFF; w.ld = DFF; w.K = DM; w.N = DFF;
        w.gain = P.in[second ? I_F2N : I_F1N] + l * DM; w.dst = (bf16_t*)(wl + (second ? WO6 : WO1)); w.Kdst = DM; w.mode = 1; w.rowoff = up ? 128 : 0;
    } else if (j == 2 || j == 13) {
        w.src = P.in[j == 2 ? I_F1D : I_F2D] + (size_t)l * DFF * DM; w.ld = DM; w.K = DFF; w.N = DM; w.dst = (bf16_t*)(wl + (j == 2 ? WO2 : WO7)); w.Kdst = DFF;
    } else if (j == 3) {
        w.src = P.in[I_WIN] + (size_t)l * DM * INC; w.ld = INC; w.K = DM; w.N = INC; w.gain = P.in[I_MN] + l * DM; w.dst = (bf16_t*)(wl + WO3); w.Kdst = DM; w.mode = 2;
    } else if (j >= 4 && j <= 6) {
        const int i = j - 4; w.src = P.in[I_WMG] + (size_t)(l * 3 + i) * DM * DM; w.ld = DM; w.K = DM; w.N = DM; w.gain = P.in[I_MN] + l * DM; w.dst = (bf16_t*)(wl + WO3); w.Kdst = DM; w.rowoff = INC + i * DM;
    } else if (j >= 7 && j <= 9) {
        const int i = j - 7; w.src = P.in[I_WB] + (size_t)(l * 3 + i) * 512 * DM; w.ld = DM; w.K = 512; w.N = DM; w.dst = (bf16_t*)(wl + WO4); w.Kdst = 512; w.rowoff = i * DM;
    } else {
        w.src = P.in[I_WO] + (size_t)l * DM * DM; w.ld = DM; w.K = DM; w.N = DM; w.dst = (bf16_t*)(wl + WO5); w.Kdst = DM;
    }
    return w;
}
DI void wt_tile(const WJob& w, int tile, LAS float* scr, int tid) {
    const int nbn = w.N / 64, kb = tile / nbn, nb = tile % nbn, k0 = kb * 64, n0 = nb * 64;
    float scale = 1.f;
    if (w.mode == 2) { if (n0 >= 1536 && n0 < 2048) scale = 0.08838834764831845f; else if (n0 >= 3584 && n0 < 4096) scale = 0.125f * LOG2E; }
#pragma unroll
    for (int i = 0; i < 8; ++i) { const int kk = i * 8 + (tid >> 6), nn = tid & 63;
        float v = w.src[(size_t)(k0 + kk) * w.ld + n0 + nn] * scale; if (w.gain) v *= w.gain[k0 + kk];
        scr[kk * 65 + nn] = v; }
    __syncthreads();
    { const int n = tid >> 3, kc = tid & 7, ng = n0 + n; int row;
      if (w.mode == 1) row = (ng >> 7) * 256 + w.rowoff + (ng & 127);
      else if (w.mode == 2 && ng >= 1536 && ng < 2560) { const int pnn = ng >> 8, cl = ng & 255, hh = cl >> 7, d = cl & 127; row = pnn * 256 + (d < 64 ? hh * 64 + d : 128 + hh * 64 + (d - 64)); }
      else row = w.rowoff + ng;
      const LAS float* s = scr + (8 * kc) * 65 + n;
      u32x4 o; o.x = pk2(s[0], s[65]); o.y = pk2(s[2 * 65], s[3 * 65]); o.z = pk2(s[4 * 65], s[5 * 65]); o.w = pk2(s[6 * 65], s[7 * 65]);
      *(u32x4*)(w.dst + (size_t)row * w.Kdst + w.koff + k0 + 8 * kc) = o; }
    __syncthreads();
}
DI float wave_sum(float v) {
#pragma unroll
    for (int o = 1; o < 64; o <<= 1) v += __shfl_xor(v, o);
    return v;
}
DI void prologue(const Params& P, LAS unsigned char* lds) {
    const int tid = otid(), lane = tid & 63, wid = tid >> 6, G = gridDim.x;
    LAS float* scr = (LAS float*)lds;
    for (int l = 0; l < 2; ++l)
        for (int j = 0; j < 14; ++j) { const WJob w = get_job(P, l, j); const int ntile = (w.K / 64) * (w.N / 64);
            for (int t = obid(); t < ntile; t += G) wt_tile(w, t, scr, tid); }
    if (blockIdx.x == 0) { unsigned* bw = (unsigned*)(P.ws + WS_BAR); for (int i = tid; i < XCD_BAR_WORDS; i += 512) bw[i] = 0u; }
    const float* x = P.in[I_X]; bf16_t* xb = (bf16_t*)(P.ws + WS_XB); float* ssq = (float*)(P.ws + WS_SSQ);
    for (int row = obid() * 8 + wid; row < MTOK; row += G * 8) {
        const f32x4* xr = (const f32x4*)(x + (size_t)row * DM) + lane; float s = 0.f;
        u32x2* o8 = (u32x2*)(xb + (size_t)row * DM) + lane;
#pragma unroll
        for (int j = 0; j < 4; ++j) { const f32x4 v = xr[64 * j]; s += (v.x * v.x + v.y * v.y) + (v.z * v.z + v.w * v.w); u32x2 o; o.x = pk2(v.x, v.y); o.y = pk2(v.z, v.w); o8[64 * j] = o; }
        s = wave_sum(s);
        if (lane < 16) ssq[(size_t)row * 16 + lane] = lane == 0 ? s : 0.f;
    }
    float* cosT = (float*)(P.ws + WS_COS); float* sinT = (float*)(P.ws + WS_SIN);
    for (int idx = obid() * 512 + tid; idx < SEQ * 64; idx += G * 512) {
        const int pos = idx >> 6, i = idx & 63;
        const float ang = (float)pos * P.invf[i];
        const double rev = (double)ang * 0.15915494309189535; const float fr = (float)(rev - floor(rev));
        cosT[idx] = __builtin_amdgcn_cosf(fr); sinT[idx] = __builtin_amdgcn_sinf(fr);
    }
}

DI void conv_phase(const Params& P, int l, int dry = 0) {
    bf16_t* cols = (bf16_t*)(P.ws + WS_COLS); const float* cw = P.in[I_CW] + l * 3 * 512;
    const int gt = obid() * 512 + otid(), stride = gridDim.x * 512;
    for (int it = gt; it < (HROWS / 8) * 64; it += stride) {
        const int cg8 = it & 63, t0 = (it >> 6) * 8, ch = cg8 * 8;
        float w0[8], w1[8], w2[8], z1[8], z2[8];
#pragma unroll
        for (int e = 0; e < 8; ++e) { w0[e] = cw[ch + e]; w1[e] = cw[512 + ch + e]; w2[e] = cw[1024 + ch + e]; z1[e] = 0.f; z2[e] = 0.f; }
        if ((t0 & (SEQ - 1)) != 0) {
            const u32x4 u1 = *(const u32x4*)(cols + (size_t)(t0 - 1) * INC + ch), c1 = *(const u32x4*)(cols + (size_t)(t0 - 1) * INC + 1024 + ch);
            const u32x4 u2 = *(const u32x4*)(cols + (size_t)(t0 - 2) * INC + ch), c2 = *(const u32x4*)(cols + (size_t)(t0 - 2) * INC + 1024 + ch);
#pragma unroll
            for (int e = 0; e < 4; ++e) { z1[2 * e] = bflo(u1[e]) * bflo(c1[e]); z1[2 * e + 1] = bfhi(u1[e]) * bfhi(c1[e]); z2[2 * e] = bflo(u2[e]) * bflo(c2[e]); z2[2 * e + 1] = bfhi(u2[e]) * bfhi(c2[e]); }
        }
#pragma unroll
        for (int e4 = 0; e4 < 8; e4 += 4) {
            u32x4 uu[4], bb[4], cc[4];
#pragma unroll
            for (int q = 0; q < 4; ++q) { const bf16_t* rp = cols + (size_t)(t0 + e4 + q) * INC + ch; uu[q] = *(const u32x4*)rp; bb[q] = *(const u32x4*)(rp + 512); cc[q] = *(const u32x4*)(rp + 1024); }
            asm volatile("" ::: "memory");
#pragma unroll
            for (int q = 0; q < 4; ++q) {
                float y[8];
#pragma unroll
                for (int e = 0; e < 4; ++e) {
                    const float za = bflo(uu[q][e]) * bflo(cc[q][e]), zb = bfhi(uu[q][e]) * bfhi(cc[q][e]);
                    y[2 * e] = bflo(bb[q][e]) * (w0[2 * e] * z2[2 * e] + w1[2 * e] * z1[2 * e] + w2[2 * e] * za);
                    y[2 * e + 1] = bfhi(bb[q][e]) * (w0[2 * e + 1] * z2[2 * e + 1] + w1[2 * e + 1] * z1[2 * e + 1] + w2[2 * e + 1] * zb);
                    z2[2 * e] = z1[2 * e]; z2[2 * e + 1] = z1[2 * e + 1]; z1[2 * e] = za; z1[2 * e + 1] = zb;
                }
                u32x4 o; o.x = pk2(y[0], y[1]); o.y = pk2(y[2], y[3]); o.z = pk2(y[4], y[5]); o.w = pk2(y[6], y[7]);
                if (!dry) *(u32x4*)(cols + (size_t)(t0 + e4 + q) * INC + 512 + ch) = o;
            }
            asm volatile("" ::: "memory");
        }
    }
}

constexpr int RS = 136;
DI float ret_lg(int hh) { return log2f(1.0f - exp2f(-5.0f - (float)hh)); }
DI void ret_local_unit(const Params& P, LAS unsigned char* lds, int unit) {
    const int tid = otid(), wid = tid >> 6, lane = tid & 63, r = lane & 31, h = lane >> 5;
    const int bl = unit >> 6, hh = (unit >> 4) & 3, seg = unit & 15, rowbase = bl * SEQ + seg * 512;
    const bf16_t* cols = (const bf16_t*)(P.ws + WS_COLS); float* T = (float*)(P.ws + WS_T) + (size_t)unit * 16384;
    LAS bf16_t* Ks = (LAS bf16_t*)lds; LAS bf16_t* Vs = Ks + 64 * RS;
    const float lg = ret_lg(hh);
    const int a = wid >> 1, b0 = (wid & 1) * 2, tg = (lane >> 4) & 1, tq = (lane & 15) >> 2, tp = lane & 3;
    f32x16 acc[2];
#pragma unroll
    for (int i = 0; i < 16; ++i) { acc[0][i] = 0.f; acc[1][i] = 0.f; }
    for (int c = 0; c < 8; ++c) {
        __syncthreads();
#pragma unroll
        for (int e = 0; e < 2; ++e) { const int idx = tid + 512 * e, row = idx >> 4, sg = idx & 15;
            const bf16_t* gp = cols + (size_t)(rowbase + c * 64 + row) * INC + hh * 128 + sg * 8;
            const u32x4 kv = *(const u32x4*)(gp + 2048), vv = *(const u32x4*)(gp + 2560);
            const float sc = exp2f(lg * (float)(511 - (c * 64 + row)));
            u32x4 ks; ks.x = pk2(bflo(kv.x) * sc, bfhi(kv.x) * sc); ks.y = pk2(bflo(kv.y) * sc, bfhi(kv.y) * sc); ks.z = pk2(bflo(kv.z) * sc, bfhi(kv.z) * sc); ks.w = pk2(bflo(kv.w) * sc, bfhi(kv.w) * sc);
            *(LAS u32x4*)(Ks + row * RS + sg * 8) = ks; *(LAS u32x4*)(Vs + row * RS + sg * 8) = vv; }
        __syncthreads();
#pragma unroll
        for (int s = 0; s < 4; ++s) {
            const int tr0 = (16 * s + 8 * h + tq) * RS + 16 * tg + 4 * tp;
            const bf16x8 af = cat8(trd(Ks + tr0 + 32 * a), trd(Ks + tr0 + 4 * RS + 32 * a));
            const bf16x8 bf0 = cat8(trd(Vs + tr0 + 32 * b0), trd(Vs + tr0 + 4 * RS + 32 * b0)), bf1 = cat8(trd(Vs + tr0 + 32 * (b0 + 1)), trd(Vs + tr0 + 4 * RS + 32 * (b0 + 1)));
            acc[0] = MFMA32(af, bf0, acc[0]); acc[1] = MFMA32(af, bf1, acc[1]);
        }
    }
#pragma unroll
    for (int bb = 0; bb < 2; ++bb)
#pragma unroll
        for (int i = 0; i < 16; ++i) T[(size_t)(32 * a + crow(i, h)) * 128 + 32 * (b0 + bb) + r] = acc[bb][i];
}
DI void ret_scan_unit(const Params& P, LAS unsigned char* lds, int unit, int dry = 0) {
    const int tid = otid(), wid = tid >> 6, lane = tid & 63, r = lane & 31, h = lane >> 5;
    const int bl = unit >> 6, hh = (unit >> 4) & 3, seg = unit & 15, rowbase = bl * SEQ + seg * 512;
    bf16_t* cols = (bf16_t*)(P.ws + WS_COLS); const float* T = (const float*)(P.ws + WS_T);
    LAS bf16_t* Qs = (LAS bf16_t*)lds; LAS bf16_t* Ks = Qs + 64 * RS; LAS bf16_t* Kd = Ks + 64 * RS; LAS bf16_t* Vs = Kd + 64 * RS; LAS bf16_t* St = Vs + 64 * RS;
    LAS float* red = (LAS float*)(St + 128 * RS);
    const float lg = ret_lg(hh);
    const int a = wid >> 1, b0 = (wid & 1) * 2, nt = wid >> 2, vt = wid & 3, tg = (lane >> 4) & 1, tq = (lane & 15) >> 2, tp = lane & 3;
    f32x16 Sacc[2];
#pragma unroll
    for (int i = 0; i < 16; ++i) { Sacc[0][i] = 0.f; Sacc[1][i] = 0.f; }
    for (int p = 0; p < seg; ++p) {
        const float f = exp2f(lg * 512.0f * (float)(seg - 1 - p)); const float* Tp = T + (size_t)(unit - seg + p) * 16384;
#pragma unroll
        for (int bb = 0; bb < 2; ++bb)
#pragma unroll
            for (int i = 0; i < 16; ++i) Sacc[bb][i] += f * Tp[(size_t)(32 * a + crow(i, h)) * 128 + 32 * (b0 + bb) + r];
    }
    const float g64 = exp2f(lg * 64.0f);
    u32x4 pq[2], pk[2], pv[2];
#pragma unroll
    for (int e = 0; e < 2; ++e) { const int idx = tid + 512 * e, row = idx >> 4, sg = idx & 15; const bf16_t* gp = cols + (size_t)(rowbase + row) * INC + hh * 128 + sg * 8;
        pq[e] = *(const u32x4*)(gp + 1536); pk[e] = *(const u32x4*)(gp + 2048); pv[e] = *(const u32x4*)(gp + 2560); }
    __syncthreads();
    for (int c = 0; c < 8; ++c) {
#pragma unroll
        for (int bb = 0; bb < 2; ++bb)
#pragma unroll
            for (int g4 = 0; g4 < 4; ++g4) { u32x2 w; w.x = pk2(Sacc[bb][4 * g4], Sacc[bb][4 * g4 + 1]); w.y = pk2(Sacc[bb][4 * g4 + 2], Sacc[bb][4 * g4 + 3]);
                *(LAS u32x2*)(St + (32 * (b0 + bb) + r) * RS + 32 * a + 8 * g4 + 4 * h) = w; }
#pragma unroll
        for (int e = 0; e < 2; ++e) { const int idx = tid + 512 * e, row = idx >> 4, sg = idx & 15;
            const u32x4 qv = pq[e], kv = pk[e], vv = pv[e];
            const float sc = ex2(lg * (float)(63 - row));
            u32x4 ks; ks.x = pk2(bflo(kv.x) * sc, bfhi(kv.x) * sc); ks.y = pk2(bflo(kv.y) * sc, bfhi(kv.y) * sc); ks.z = pk2(bflo(kv.z) * sc, bfhi(kv.z) * sc); ks.w = pk2(bflo(kv.w) * sc, bfhi(kv.w) * sc);
            *(LAS u32x4*)(Qs + row * RS + sg * 8) = qv; *(LAS u32x4*)(Ks + row * RS + sg * 8) = kv; *(LAS u32x4*)(Kd + row * RS + sg * 8) = ks; *(LAS u32x4*)(Vs + row * RS + sg * 8) = vv; }
        __syncthreads();
        if (c + 1 < 8) {
#pragma unroll
            for (int e = 0; e < 2; ++e) { const int idx = tid + 512 * e, row = idx >> 4, sg = idx & 15; const bf16_t* gp = cols + (size_t)(rowbase + (c + 1) * 64 + row) * INC + hh * 128 + sg * 8;
                pq[e] = *(const u32x4*)(gp + 1536); pk[e] = *(const u32x4*)(gp + 2048); pv[e] = *(const u32x4*)(gp + 2560); }
        }
        f32x16 pT[2];
#pragma unroll
        for (int i = 0; i < 16; ++i) { pT[0][i] = 0.f; pT[1][i] = 0.f; }
#pragma unroll
        for (int ks = 0; ks < 8; ++ks) {
            const bf16x8 qf = *(const LAS bf16x8*)(Qs + (32 * nt + r) * RS + 16 * ks + 8 * h);
            const bf16x8 k0 = *(const LAS bf16x8*)(Ks + r * RS + 16 * ks + 8 * h), k1 = *(const LAS bf16x8*)(Ks + (32 + r) * RS + 16 * ks + 8 * h);
            pT[0] = MFMA32(k0, qf, pT[0]); pT[1] = MFMA32(k1, qf, pT[1]);
        }
        const int nq = 32 * nt + r;
#pragma unroll
        for (int mt = 0; mt < 2; ++mt)
#pragma unroll
            for (int i = 0; i < 16; ++i) { const int mm = 32 * mt + crow(i, h); const int dd = nq > mm ? nq - mm : mm - nq; pT[mt][i] *= ex2(lg * (float)dd); }
        f32x16 O1, O2;
#pragma unroll
        for (int i = 0; i < 16; ++i) { O1[i] = 0.f; O2[i] = 0.f; }
#pragma unroll
        for (int mt = 0; mt < 2; ++mt)
#pragma unroll
            for (int s = 0; s < 2; ++s) {
                const bf16x8 af = pack8(pT[mt][8 * s], pT[mt][8 * s + 1], pT[mt][8 * s + 2], pT[mt][8 * s + 3], pT[mt][8 * s + 4], pT[mt][8 * s + 5], pT[mt][8 * s + 6], pT[mt][8 * s + 7]);
                const int tr0 = (32 * mt + 16 * s + 4 * h + tq) * RS + 32 * vt + 16 * tg + 4 * tp;
                const bf16x8 bf = cat8(trd(Vs + tr0), trd(Vs + tr0 + 8 * RS));
                O1 = MFMA32(af, bf, O1);
            }
#pragma unroll
        for (int ks = 0; ks < 8; ++ks) {
            const bf16x8 qf = *(const LAS bf16x8*)(Qs + (32 * nt + r) * RS + 16 * ks + 8 * h);
            const bf16x8 sf = *(const LAS bf16x8*)(St + (32 * vt + r) * RS + 16 * ks + 8 * h);
            O2 = MFMA32(qf, sf, O2);
        }
#pragma unroll
        for (int i = 0; i < 16; ++i) { const int n = 32 * nt + crow(i, h); O1[i] += ex2(lg * (float)(n + 1)) * O2[i]; }
#pragma unroll
        for (int i = 0; i < 16; ++i) { float v = O1[i] * O1[i];
            v += __shfl_xor(v, 1); v += __shfl_xor(v, 2); v += __shfl_xor(v, 4); v += __shfl_xor(v, 8); v += __shfl_xor(v, 16);
            if (r == 0) red[(32 * nt + crow(i, h)) * 4 + vt] = v; }
#pragma unroll
        for (int i = 0; i < 16; ++i) { Sacc[0][i] *= g64; Sacc[1][i] *= g64; }
#pragma unroll
        for (int s = 0; s < 4; ++s) {
            const int tr0 = (16 * s + 8 * h + tq) * RS + 16 * tg + 4 * tp;
            const bf16x8 af = cat8(trd(Kd + tr0 + 32 * a), trd(Kd + tr0 + 4 * RS + 32 * a));
            const bf16x8 bf0 = cat8(trd(Vs + tr0 + 32 * b0), trd(Vs + tr0 + 4 * RS + 32 * b0)), bf1 = cat8(trd(Vs + tr0 + 32 * (b0 + 1)), trd(Vs + tr0 + 4 * RS + 32 * (b0 + 1)));
            Sacc[0] = MFMA32(af, bf0, Sacc[0]); Sacc[1] = MFMA32(af, bf1, Sacc[1]);
        }
        __syncthreads();
#pragma unroll
        for (int i = 0; i < 16; ++i) { const int n = 32 * nt + crow(i, h); const f32x4 q = *(const LAS f32x4*)(red + n * 4);
            const float rn = __builtin_amdgcn_rsqf(((q.x + q.y) + (q.z + q.w)) * (1.f / 128.f) + EPS);
            bf16_t* gp = cols + (size_t)(rowbase + c * 64 + n) * INC + 3072 + hh * 128 + 32 * vt + r;
            const float gv = bf2f(*gp); const bf16_t yv = f2bf(gv * sigm(gv) * O1[i] * rn); if (!dry) *gp = yv; }
        __syncthreads();
    }
}

constexpr int VS = 72;
constexpr int ATT_BIAS_OFF = 0, ATT_SCR_OFF = 8704, ATT_V_OFF = 10240;
DI void attn_bias(f32x16 (&sT)[2], const LAS float* bt, int j, int n, int h) {
    if (j <= 5) { const float b = bt[256];
#pragma unroll
        for (int i = 0; i < 16; ++i) { sT[0][i] += b; sT[1][i] += b; }
    } else {
#pragma unroll
        for (int t = 0; t < 2; ++t)
#pragma unroll
            for (int i = 0; i < 16; ++i) { const int mm = 32 * t + crow(i, h); int dist = 64 * (8 - j) + n - mm; dist = dist > 128 ? 128 : dist; sT[t][i] += bt[dist + 128]; }
    }
}
DI void attn_unit(bf16_t* cols, LAS unsigned char* lds, int wid, int lane, int bl, int hh, int c, int qh, int dry) {
    const int r = lane & 31, h = lane >> 5, tg = (lane >> 4) & 1, tq = (lane & 15) >> 2, tp = lane & 3;
    const LAS float* bt = (const LAS float*)(lds + ATT_BIAS_OFF) + hh * 264;
    LAS float* scr = (LAS float*)(lds + ATT_SCR_OFF) + wid * 32;
    LAS bf16_t* Vs = (LAS bf16_t*)(lds + ATT_V_OFF + wid * (64 * VS * 2));
    const int seqbase = bl * SEQ, tq0 = seqbase + c * 64 + 32 * qh, n = 32 * qh + r;
    bf16x8 qf[4];
#pragma unroll
    for (int d0 = 0; d0 < 4; ++d0) qf[d0] = *(const bf16x8*)(cols + (size_t)(tq0 + r) * INC + 3584 + hh * 64 + 16 * d0 + 8 * h);
    const int j0 = c >= 8 ? 0 : 8 - c;
    bf16x8 kf[2][4]; u32x4 vv[8];
    { const bf16_t* kb = cols + (size_t)(seqbase + (c - 8 + j0) * 64) * INC + 4096 + hh * 64;
#pragma unroll
      for (int t = 0; t < 2; ++t)
#pragma unroll
          for (int d0 = 0; d0 < 4; ++d0) kf[t][d0] = *(const bf16x8*)(kb + (size_t)(32 * t + r) * INC + 16 * d0 + 8 * h);
#pragma unroll
      for (int e = 0; e < 8; ++e) { const int idx = e * 64 + lane; vv[e] = *(const u32x4*)(kb + 512 + (size_t)(idx >> 3) * INC + (idx & 7) * 8); } }
    float mrow = -1e30f, lsum = 0.f;
    f32x16 O[2];
#pragma unroll
    for (int i = 0; i < 16; ++i) { O[0][i] = 0.f; O[1][i] = 0.f; }
    for (int j = j0; j <= 8; ++j) {
        const bf16_t* kbn = cols + (size_t)(seqbase + (c - 7 + j) * 64) * INC + 4096 + hh * 64;
        f32x16 sT[2];
#pragma unroll
        for (int i = 0; i < 16; ++i) { sT[0][i] = 0.f; sT[1][i] = 0.f; }
#pragma unroll
        for (int d0 = 0; d0 < 4; ++d0) { sT[0] = MFMA32(kf[0][d0], qf[d0], sT[0]); sT[1] = MFMA32(kf[1][d0], qf[d0], sT[1]); }
        asm volatile("" ::: "memory");
        if (j < 8) {
#pragma unroll
            for (int t = 0; t < 2; ++t)
#pragma unroll
                for (int d0 = 0; d0 < 4; ++d0) kf[t][d0] = *(const bf16x8*)(kbn + (size_t)(32 * t + r) * INC + 16 * d0 + 8 * h);
        }
        asm volatile("" ::: "memory");
        attn_bias(sT, bt, j, n, h);
        float mx = fmaxf(sT[0][0], sT[1][0]);
#pragma unroll
        for (int i = 1; i < 16; ++i) mx = fmaxf(mx, fmaxf(sT[0][i], sT[1][i]));
        mx = fmaxf(mx, __shfl_xor(mx, 32));
        if (__any(mx > mrow)) {
            const float mnew = fmaxf(mrow, mx), alpha = ex2(mrow - mnew); mrow = mnew; lsum *= alpha;
            if (h == 0) scr[r] = alpha;
            asm volatile("s_waitcnt lgkmcnt(0)" ::: "memory");
#pragma unroll
            for (int g4 = 0; g4 < 4; ++g4) { const f32x4 a4 = *(const LAS f32x4*)(scr + 8 * g4 + 4 * h);
#pragma unroll
                for (int e = 0; e < 4; ++e) { O[0][4 * g4 + e] *= a4[e]; O[1][4 * g4 + e] *= a4[e]; } }
            asm volatile("s_waitcnt lgkmcnt(0)" ::: "memory");
        }
#pragma unroll
        for (int t = 0; t < 2; ++t)
#pragma unroll
            for (int i = 0; i < 16; ++i) { const float p = ex2(sT[t][i] - mrow); sT[t][i] = p; lsum += p; }
#pragma unroll
        for (int e = 0; e < 8; ++e) { const int idx = e * 64 + lane; *(LAS u32x4*)(Vs + (idx >> 3) * VS + (idx & 7) * 8) = vv[e]; }
        asm volatile("s_waitcnt lgkmcnt(0)" ::: "memory");
        if (j < 8) {
#pragma unroll
            for (int e = 0; e < 8; ++e) { const int idx = e * 64 + lane; vv[e] = *(const u32x4*)(kbn + 512 + (size_t)(idx >> 3) * INC + (idx & 7) * 8); }
        }
        asm volatile("" ::: "memory");
#pragma unroll
        for (int t = 0; t < 2; ++t)
#pragma unroll
            for (int s = 0; s < 2; ++s) {
                const bf16x8 af = pack8(sT[t][8 * s], sT[t][8 * s + 1], sT[t][8 * s + 2], sT[t][8 * s + 3], sT[t][8 * s + 4], sT[t][8 * s + 5], sT[t][8 * s + 6], sT[t][8 * s + 7]);
                const int tr0 = (32 * t + 16 * s + 4 * h + tq) * VS + 16 * tg + 4 * tp;
#pragma unroll
                for (int dh = 0; dh < 2; ++dh) { const bf16x8 bf = cat8(trd(Vs + tr0 + 32 * dh), trd(Vs + tr0 + 8 * VS + 32 * dh)); O[dh] = MFMA32(af, bf, O[dh]); }
            }
        asm volatile("s_waitcnt lgkmcnt(0)" ::: "memory");
    }
    lsum += __shfl_xor(lsum, 32);
    if (h == 0) scr[r] = lsum;
    asm volatile("s_waitcnt lgkmcnt(0)" ::: "memory");
#pragma unroll
    for (int i = 0; i < 16; ++i) { const int q = crow(i, h); const float inv = __builtin_amdgcn_rcpf(scr[q]);
        bf16_t* op = cols + (size_t)(tq0 + q) * INC + 3584 + hh * 64 + r;
        const bf16_t o0 = f2bf(O[0][i] * inv), o1 = f2bf(O[1][i] * inv); if (!dry) { op[0] = o0; op[32] = o1; } }
    asm volatile("s_waitcnt lgkmcnt(0)" ::: "memory");
}
DI void attn_phase(const Params& P, LAS unsigned char* lds, int l, int dry = 0) {
    const int tid = otid(), lane = tid & 63, wid = __builtin_amdgcn_readfirstlane(tid >> 6);
    LAS float* bias = (LAS float*)(lds + ATT_BIAS_OFF); const float* rb = P.in[I_RB] + l * 8 * 257;
    __syncthreads();
    for (int i = tid; i < 8 * 257; i += 512) bias[(i / 257) * 264 + (i % 257)] = rb[i] * LOG2E;
    __syncthreads();
    bf16_t* cols = (bf16_t*)(P.ws + WS_COLS);
    for (int u = obid() * 8 + wid; u < 8192; u += gridDim.x * 8) {
        const int qh = u & 1, c = (u >> 1) & 127, hh = (u >> 8) & 7, bl = u >> 11;
        attn_unit(cols, lds, wid, lane, bl, hh, c, qh, dry);
    }
}

DI void final_norm(const Params& P, int dry = 0) {
    const int tid = otid(), lane = tid & 63, wid = tid >> 6; const float* ssq = (const float*)(P.ws + WS_SSQ); const float* w = P.in[I_FN];
    for (int row = obid() * 8 + wid; row < MTOK; row += gridDim.x * 8) {
        const float rs = row_rstd(ssq, row); f32x4* xr = (f32x4*)(P.out + (size_t)row * DM) + lane; const f32x4* wr = (const f32x4*)w + lane;
#pragma unroll
        for (int j = 0; j < 4; ++j) { const f32x4 v = xr[64 * j], g = wr[64 * j]; const f32x4 o = v * rs * g; if (!dry) xr[64 * j] = o; }
    }
}


#define XB_TMO      128
#define XB_XCNT(j)  (256  + 64 * (j))
#define XB_XSUB(j)  (1280 + 64 * (j))
#define XB_XGEN(j)  (2304 + 64 * (j))
#define XB_TOP      3328
#define XB_TOPGEN   3392
#define XB_SPIN_CAP (1u << 22)
DI unsigned xb_ld(unsigned* p)              { return __hip_atomic_load(p, __ATOMIC_RELAXED, __HIP_MEMORY_SCOPE_AGENT); }
DI unsigned xb_add(unsigned* p, unsigned v) { return __hip_atomic_fetch_add(p, v, __ATOMIC_RELAXED, __HIP_MEMORY_SCOPE_AGENT); }
DI unsigned xb_xcc_id() { return (unsigned)__builtin_amdgcn_s_getreg((3 << 11) | 20) & 0xFu; }
#define XB_SPIN(cond, bar) do { unsigned _sp = 0; while (cond) { __builtin_amdgcn_s_sleep(1); \
    if ((++_sp & 255u) == 0u) { if (xb_ld(&(bar)[XB_TMO])) break; if (_sp > XB_SPIN_CAP) { atomicAdd(&(bar)[XB_TMO], 1u); break; } } } } while (0)
struct XcdBarrier { unsigned* bar; unsigned x; volatile LAS unsigned* st; };
DI XcdBarrier xcd_barrier_post(unsigned* bar, volatile LAS unsigned* st) {
    XcdBarrier b; b.bar = bar; b.x = xb_xcc_id(); b.st = st;
    if (threadIdx.x == 0) (void)xb_add(&bar[XB_XCNT(b.x)], 1u);
    return b;
}
DI void xcd_barrier_complete(unsigned* bar, unsigned x, unsigned& nloc, unsigned& nx) {
    const unsigned G = gridDim.x * gridDim.y * gridDim.z;
    unsigned sum, cnt, mine, sp = 0u;
    for (;;) {
        sum = 0u; cnt = 0u; mine = 0u;
#pragma unroll
        for (unsigned j = 0; j < 16; ++j) { const unsigned c = xb_ld(&bar[XB_XCNT(j)]); sum += c; cnt += (c > 0u) ? 1u : 0u; mine = (j == x) ? c : mine; }
        if (sum == G) break;
        __builtin_amdgcn_s_sleep(1);
        if ((++sp & 255u) == 0u) { if (xb_ld(&bar[XB_TMO])) break; if (sp > XB_SPIN_CAP) { atomicAdd(&bar[XB_TMO], 1u); break; } }
    }
    nloc = mine > 0u ? mine : 1u; nx = cnt > 0u ? cnt : 1u;
}
DI void xcd_barrier(const XcdBarrier& b) {
    asm volatile("s_waitcnt vmcnt(0)" ::: "memory");
    __syncthreads();
    if (threadIdx.x == 0) {
        unsigned* bar = b.bar;
        __builtin_amdgcn_s_waitcnt(0);
        unsigned nloc = b.st[0], nx = b.st[1];
        if (nloc == 0u) { xcd_barrier_complete(bar, b.x, nloc, nx); b.st[0] = nloc; b.st[1] = nx; }
        const unsigned old = xb_add(&bar[XB_XSUB(b.x)], 1u);
        const unsigned gen = old / nloc;
        if (old + 1u == (gen + 1u) * nloc) {
            __builtin_amdgcn_fence(__ATOMIC_RELEASE, "agent");
            asm volatile("s_waitcnt vmcnt(0)" ::: "memory");
            const unsigned og = xb_add(&bar[XB_TOP], 1u);
            const unsigned tg = og / nx;
            if (og + 1u == (tg + 1u) * nx) xb_add(&bar[XB_TOPGEN], 1u);
            else XB_SPIN(xb_ld(&bar[XB_TOPGEN]) == tg, bar);
            __builtin_amdgcn_fence(__ATOMIC_ACQUIRE, "agent");
            xb_add(&bar[XB_XGEN(b.x)], 1u);
            asm volatile("s_waitcnt vmcnt(0)" ::: "memory");
        } else {
            XB_SPIN(xb_ld(&bar[XB_XGEN(b.x)]) == gen, bar);
            __builtin_amdgcn_fence(__ATOMIC_ACQUIRE, "agent");
            asm volatile("s_waitcnt vmcnt(0)" ::: "memory");
        }
    }
    __syncthreads();
}

constexpr int NPHASE = 30;
__global__ void __launch_bounds__(512, 2) fwd_kernel(Params Parg) {
    extern __shared__ __attribute__((aligned(16))) unsigned char lds_raw[];
    LAS unsigned char* lds = (LAS unsigned char*)lds_raw;
    const int G = gridDim.x;
    typedef const __attribute__((address_space(4))) Params* KP;
    const KP Pk = (KP)__builtin_amdgcn_kernarg_segment_ptr();
    const int ph_lo = Pk->lo, ph_hi = Pk->hi;
#define XB ((bf16_t*)(ws + WS_XB))
#define COLS ((bf16_t*)(ws + WS_COLS))
#define GB ((bf16_t*)(ws + WS_G))
#define HID ((bf16_t*)(ws + WS_HID))
#define SSQ ((float*)(ws + WS_SSQ))
    volatile LAS unsigned* MISC = (volatile LAS unsigned*)(lds + 131072 + 64);
    if (threadIdx.x < 4) MISC[threadIdx.x] = 0u;
    __syncthreads();
    XcdBarrier bar; bar.bar = (unsigned*)(Pk->ws + WS_BAR); bar.x = 0; bar.st = MISC;
    for (int ph = ph_lo; ph < ph_hi; ++ph) {
        if (ph > ph_lo) {
            if (ph == ph_lo + 1) { cg::this_grid().sync(); bar = xcd_barrier_post((unsigned*)(Pk->ws + WS_BAR), MISC); }
            else xcd_barrier(bar);
        }
        KP Pp = Pk; asm volatile("" : "+s"(Pp));
        const Params& P = *(const Params*)Pp;
        unsigned char* ws = P.ws;
        if (ph == 0) { prologue(P, lds); if (PROBE == 3) prologue(P, lds); continue; }
        if (ph == NPHASE - 1) { if (PROBE == 3) final_norm(P, P.hi != 12345); final_norm(P); continue; }
        const int l = (ph - 1) / 14, k = (ph - 1) % 14;
        unsigned char* wl = ws + WS_WT + (size_t)l * WLAYER;
        pg8::StaticOrder S;
        if (k == 0 || k == 12) {
            pg8::Gemm g{XB, (const bf16_t*)(wl + (k == 0 ? WO1 : WO6)), DM, DM}; S.init(MTOK, 2 * DFF, G, obid());
            pg8::EpiGateUp E{HID, SSQ, 0};
#if PROBE == 11
            { pg8::EpiGateUp Ed = E; Ed.dry = (P.hi != 12345); pg8::gemm_phase<pg8::EpiGateUp>(lds, g, S, Ed); }
#endif
            for (int rep = 0; rep < (PROBE == 2 ? 2 : 1); ++rep) pg8::gemm_phase<pg8::EpiGateUp>(lds, g, S, E);
        } else if (k == 1 || k == 13) {
            pg8::Gemm g{HID, (const bf16_t*)(wl + (k == 1 ? WO2 : WO7)), DFF, DFF}; S.init(MTOK, DM, G, obid());
            pg8::EpiResid E{(l == 0 && k == 1) ? P.in[I_X] : (const float*)nullptr, (l == 1 && k == 13) ? P.out : (float*)nullptr, XB, SSQ, 0.5f, 0, 0, XB, SSQ};
#if PROBE == 9
            { pg8::EpiResid Ed = E; Ed.xout32 = nullptr; Ed.xbo = (bf16_t*)(ws + (P.hi != 12345 ? 848 * MiB : WS_XB)); Ed.ssqo = (float*)(ws + (P.hi != 12345 ? 980 * MiB : WS_SSQ)); pg8::gemm_phase<pg8::EpiResid>(lds, g, S, Ed); }
#endif
#if PROBE == 4 || PROBE == 10
            { pg8::EpiResid Ed = E; Ed.dry = (P.hi != 12345); pg8::gemm_phase<pg8::EpiResid>(lds, g, S, Ed); }
#endif
            pg8::gemm_phase<pg8::EpiResid>(lds, g, S, E);
        } else {
            const int half = (k - 2) / 5, kk = (k - 2) % 5, row0 = half * HROWS;
            if (kk == 0) {
                pg8::Gemm g{XB + (size_t)row0 * DM, (const bf16_t*)(wl + WO3), DM, DM}; S.init(HROWS, NCAT, G, obid());
                pg8::EpiInProj E{COLS, GB, SSQ, (const float*)(ws + WS_COS), (const float*)(ws + WS_SIN), row0, 0};
#if PROBE == 11
                { pg8::EpiInProj Ed = E; Ed.dry = (P.hi != 12345); pg8::gemm_phase<pg8::EpiInProj>(lds, g, S, Ed); }
#endif
                for (int rep = 0; rep < (PROBE == 2 ? 2 : 1); ++rep) pg8::gemm_phase<pg8::EpiInProj>(lds, g, S, E);
            } else if (kk == 1) {
#if PROBE == 1
                if (P.hi != 12345) { for (int u = obid(); u < 256; u += G) ret_local_unit(P, lds, u); conv_phase(P, l, P.hi != 12345); }
#endif
                if (HAS(4)) { for (int u = obid(); u < 256; u += G) ret_local_unit(P, lds, u);
                conv_phase(P, l); }
            } else if (kk == 2) {
#if PROBE == 1
                if (P.hi != 12345) { for (int u = obid(); u < 256; u += G) ret_scan_unit(P, lds, u, P.hi != 12345); attn_phase(P, lds, l, P.hi != 12345); }
#endif
                if (HAS(5)) for (int u = obid(); u < 256; u += G) ret_scan_unit(P, lds, u);
                if (HAS(6)) attn_phase(P, lds, l);
            } else if (kk == 3) {
                pg8::Gemm g{COLS, (const bf16_t*)(wl + WO4), 512, INC}; S.init(HROWS, DM, G, obid(), 1);
                pg8::EpiBranch E{GB, (bf16_t*)(ws + WS_MB), 0};
                pg8::gemm_phase<pg8::EpiBranch, true>(lds, g, S, E);
            } else {
                pg8::Gemm g{(const bf16_t*)(ws + WS_MB), (const bf16_t*)(wl + WO5), DM, DM}; S.init(HROWS, DM, G, obid());
                pg8::EpiResid E{nullptr, nullptr, XB, SSQ, 1.0f, row0, 0, XB, SSQ};
#if PROBE == 9
                { pg8::EpiResid Ed = E; Ed.xbo = (bf16_t*)(ws + (P.hi != 12345 ? 848 * MiB : WS_XB)); Ed.ssqo = (float*)(ws + (P.hi != 12345 ? 980 * MiB : WS_SSQ)); pg8::gemm_phase<pg8::EpiResid>(lds, g, S, Ed); }
#endif
#if PROBE == 4 || PROBE == 10
                { pg8::EpiResid Ed = E; Ed.dry = (P.hi != 12345); pg8::gemm_phase<pg8::EpiResid>(lds, g, S, Ed); }
#endif
                pg8::gemm_phase<pg8::EpiResid>(lds, g, S, E);
            }
        }
    }
}

extern "C" void kernel_launch(void* const* d_in, const int* in_sizes, int n_in, void* d_out, int out_size, void* d_ws, size_t ws_size, hipStream_t stream) {
    static int grid = 0;
    if (grid == 0) {
        if (n_in != 17 || out_size != MTOK * DM || ws_size < WS_END) { fprintf(stderr, "kernel_launch: unexpected shapes (n_in %d out %d ws %zu)\n", n_in, out_size, ws_size); grid = -1; return; }
        int dev = 0, cus = 0, per_cu = 0;
        (void)hipGetDevice(&dev); (void)hipDeviceGetAttribute(&cus, hipDeviceAttributeMultiprocessorCount, dev);
        (void)hipFuncSetAttribute((const void*)fwd_kernel, hipFuncAttributeMaxDynamicSharedMemorySize, LDS_BYTES);
        if (hipOccupancyMaxActiveBlocksPerMultiprocessor(&per_cu, (const void*)fwd_kernel, 512, LDS_BYTES) != hipSuccess || per_cu < 1) per_cu = 1;
        (void)hipGetLastError();
        if (cus <= 0) cus = 256;
        grid = cus * per_cu;
    }
    if (grid < 0) return;
    Params p{};
    for (int i = 0; i < 17; ++i) p.in[i] = (const float*)d_in[i];
    p.out = (float*)d_out; p.ws = (unsigned char*)d_ws;
    for (int i = 0; i < 64; ++i) p.invf[i] = powf(10000.0f, -((float)i / 63.0f));
#if MK_MULTI
    for (int ph = 0; ph < NPHASE; ++ph) { p.lo = ph; p.hi = ph + 1; hipLaunchKernelGGL(fwd_kernel, dim3(grid), dim3(512), LDS_BYTES, stream, p); }
#else
    p.lo = 0; p.hi = NPHASE;
    void* args[] = {&p};
    hipError_t e = hipLaunchCooperativeKernel((const void*)fwd_kernel, dim3(grid), dim3(512), args, LDS_BYTES, stream);
    if (e != hipSuccess) fprintf(stderr, "cooperative launch failed: %s (grid %d)\n", hipGetErrorString(e), grid);
#endif
}
```

```cpp
#include <hip/hip_runtime.h>
#include <hip/hip_cooperative_groups.h>
#include <cstdio>
#include <cstdint>
#include <cmath>
namespace cg = cooperative_groups;

#ifndef MK_MULTI
#define MK_MULTI 0
#endif

#ifndef PROBE
#define PROBE 0
#endif
#ifndef STAGGER
#define STAGGER 0
#endif
#ifndef PH_MASK
#define PH_MASK 0x1ff
#endif
#define HAS(x) (((PH_MASK) >> (x)) & 1)
#define DI __device__ __forceinline__
#define LAS __attribute__((address_space(3)))
typedef unsigned short bf16_t;
typedef short bf16x8 __attribute__((ext_vector_type(8)));
typedef float f32x4 __attribute__((ext_vector_type(4)));
typedef float f32x16 __attribute__((ext_vector_type(16)));
typedef unsigned u32x4 __attribute__((ext_vector_type(4)));
typedef unsigned u32x2 __attribute__((ext_vector_type(2)));
typedef float f32x2_t __attribute__((ext_vector_type(2)));
typedef __bf16 bf16x2_t __attribute__((ext_vector_type(2)));

constexpr int DM = 1024, SEQ = 8192, NBATCH = 8, MTOK = NBATCH * SEQ, DFF = 2816, INC = 5120, GZ = 3072, NCAT = INC + GZ;
constexpr int HROWS = MTOK / 2;
constexpr float EPS = 1e-6f;
constexpr float LOG2E = 1.4426950408889634f;
constexpr size_t MiB = (size_t)1 << 20;
constexpr size_t WS_BAR = 0;
constexpr size_t WS_SSQ = 1 * MiB;
constexpr size_t WS_COS = 5 * MiB, WS_SIN = 7 * MiB;
constexpr size_t WS_T = 9 * MiB;
constexpr size_t WS_WT = 26 * MiB;
constexpr size_t WO1 = 0, WO2 = WO1 + (size_t)2 * DFF * DM * 2, WO3 = WO2 + (size_t)DM * DFF * 2, WO4 = WO3 + (size_t)NCAT * DM * 2,
                 WO5 = WO4 + (size_t)GZ * 512 * 2, WO6 = WO5 + (size_t)DM * DM * 2, WO7 = WO6 + (size_t)2 * DFF * DM * 2, WLAYER = WO7 + (size_t)DM * DFF * 2;
constexpr size_t WS_XB = 144 * MiB;
constexpr size_t WS_COLS = 272 * MiB;
constexpr size_t WS_G = 592 * MiB;
constexpr size_t WS_HID = 272 * MiB;
constexpr size_t WS_MB = 784 * MiB;
constexpr size_t WS_END = 848 * MiB;
static_assert(WS_WT + 2 * WLAYER <= WS_XB && WS_HID + (size_t)MTOK * DFF * 2 <= WS_END && WS_COLS + (size_t)HROWS * INC * 2 <= WS_G, "ws map");
#define XCD_BAR_WORDS 3456
constexpr int LDS_BYTES = 147456;

DI int otid() { int t = threadIdx.x; asm volatile("" : "+v"(t)); return t; }
DI int obid() { int b = blockIdx.x; asm volatile("" : "+s"(b)); return b; }
DI unsigned pk2(float lo, float hi) { f32x2_t v = {lo, hi}; bf16x2_t b = __builtin_convertvector(v, bf16x2_t); return __builtin_bit_cast(unsigned, b); }
DI float bflo(unsigned w) { return __uint_as_float(w << 16); }
DI float bfhi(unsigned w) { return __uint_as_float(w & 0xffff0000u); }
DI float bf2f(bf16_t u) { return __uint_as_float(((unsigned)u) << 16); }
DI bf16_t f2bf(float f) { return (bf16_t)(pk2(f, 0.f) & 0xffffu); }
DI float ex2(float x) { return __builtin_amdgcn_exp2f(x); }
DI float sigm(float v) { return __builtin_amdgcn_rcpf(1.f + ex2(-LOG2E * v)); }
DI unsigned q8(float g) { return (unsigned)(g * 255.f + 0.5f); }
DI unsigned pkq4(float a, float b, float c, float d) { return q8(a) | (q8(b) << 8) | (q8(c) << 16) | (q8(d) << 24); }
DI float ub(unsigned w, int k) { return (float)((w >> (8 * k)) & 0xffu); }
DI int crow(int reg, int h) { return (reg & 3) + 8 * (reg >> 2) + 4 * h; }
#define MFMA32(a, b, c) __builtin_amdgcn_mfma_f32_32x32x16_bf16((a), (b), (c), 0, 0, 0)
DI bf16x8 pack8(float a0, float a1, float a2, float a3, float a4, float a5, float a6, float a7) {
    u32x4 p; p.x = pk2(a0, a1); p.y = pk2(a2, a3); p.z = pk2(a4, a5); p.w = pk2(a6, a7); return __builtin_bit_cast(bf16x8, p);
}
typedef short v4i16_t __attribute__((ext_vector_type(4)));
DI v4i16_t trd(const LAS bf16_t* p) { return __builtin_amdgcn_ds_read_tr16_b64_v4i16((LAS v4i16_t*)p); }
DI bf16x8 cat8(v4i16_t lo, v4i16_t hi) { return __builtin_shufflevector(lo, hi, 0, 1, 2, 3, 4, 5, 6, 7); }
#ifndef NT_STORE
#define NT_STORE 0
#endif
DI void st16(void* p, u32x4 v) {
#if NT_STORE == 1
    __builtin_nontemporal_store(v, (u32x4*)p);
#elif NT_STORE == 2
    asm volatile("global_store_dwordx4 %0, %1, off sc1" :: "v"(p), "v"(v) : "memory");
#else
    *(u32x4*)p = v;
#endif
}
DI float row_rstd(const float* ssq, int grow) {
    const f32x4* p = (const f32x4*)(ssq + (size_t)grow * 16); const f32x4 a = p[0], b = p[1], c = p[2], d = p[3];
    const float s = ((a.x + a.y) + (a.z + a.w)) + ((b.x + b.y) + (b.z + b.w)) + ((c.x + c.y) + (c.z + c.w)) + ((d.x + d.y) + (d.z + d.w));
    return __builtin_amdgcn_rsqf(s * (1.f / DM) + EPS);
}

namespace pg8 {
constexpr int BM = 256, BK = 64, HALF = 128, HTB = HALF * BK * 2, STAGE_BYTES = 8 * HTB, NXCD = 8, WGM = 8;
__host__ __device__ __forceinline__ int lds_byte(int r, int c) { const int st = (r >> 4) * 2 + (c >> 5), rr = r & 15, cc = c & 31, ob = rr * 64 + cc * 2; return st * 1024 + (ob ^ (((ob >> 9) & 1) << 5)); }
__host__ __device__ __forceinline__ void stage_rc(int b, int& R, int& C) { const int st = b / 1024, sb = b % 1024, swz = sb ^ (((sb >> 9) & 1) << 5); R = (st >> 1) * 16 + swz / 64; C = (st & 1) * 32 + (swz % 64) / 2; }
__host__ __device__ __forceinline__ int perm32(int rho) { const int n = rho >> 4, i = rho & 15; return 8 * (i >> 2) + 4 * n + (i & 3); }
struct Unit { int pm, pn; };
struct Gemm { const bf16_t* A; const bf16_t* Bt; int K, lda; int kstepA, tA; };
struct StaticOrder {
    int nM, nN, nwg, G, c;
    __device__ void init(int M, int N, int G_, int c_, int br3_ = 0) { nM = M / BM; nN = N / BM; nwg = nM * nN; G = G_; c = c_; br3 = br3_; }
    int br3;
    __device__ bool next(int i, Unit& u) const {
        if (br3) { const int b = i % 3; if (!next1(i / 3, u)) return false; u.pn += b * nN; return true; }
        return next1(i, u);
    }
    __device__ bool next1(int i, Unit& u) const {
        const long L = (long)i * G + c; if (L >= nwg) return false;
        int wgid = (int)L; { const int q = nwg / NXCD, r = nwg % NXCD, xcd = wgid % NXCD, off = wgid / NXCD; wgid = (xcd < r ? xcd * (q + 1) : r * (q + 1) + (xcd - r) * q) + off; }
        const int nig = WGM * nN, gid = wgid / nig, fm = gid * WGM, gsz = (nM - fm) < WGM ? (nM - fm) : WGM;
        u.pm = fm + ((wgid % nig) % gsz); u.pn = (wgid % nig) / gsz; return true;
    }
};
template <class Epi, bool BR = false>
DI void gemm_phase(LAS unsigned char* lds, const Gemm g, const StaticOrder& S, const Epi& E, int stagger = 0) {
    const int tid = otid(), wid = __builtin_amdgcn_readfirstlane(tid >> 6), lane = tid & 63, wr = wid >> 2, wc = wid & 3, fr = lane & 15, fq = lane >> 4;
    const int K = g.K, nt = K / BK, lda = g.lda;
    unsigned voffA[2], voffB[2];
#pragma unroll
    for (int i = 0; i < 2; ++i) { int R, C; stage_rc(tid * 16 + i * 8192, R, C); const int Rb = 64 * (R >> 5) + perm32(R & 31);
        voffA[i] = (unsigned)(R * lda + C) * 2u; voffB[i] = (unsigned)(Rb * K + C) * 2u; }
    const size_t kstep = (size_t)(BK * 2);
    const size_t hA = (size_t)HALF * lda * 2, tA = (size_t)g.tA, kstepA = (size_t)g.kstepA;
    const size_t hB = (size_t)32 * K * 2, tB = (size_t)BM * K * 2;
    const unsigned ldsw = (unsigned)wid * 1024u;
    const int aoff = lds_byte(wr * 64 + fr, fq * 8), boff = lds_byte(wc * 32 + fr, fq * 8);
#define PG8_SA(b, h) (((b) * 2 + (h)) * HTB)
#define PG8_SB(b, h) ((4 + (b) * 2 + (h)) * HTB)
#define PG8_STAGE(bufoff, gbase, voff) do { _Pragma("unroll") for (int _i = 0; _i < 2; ++_i) \
        __builtin_amdgcn_global_load_lds((const unsigned*)((const char*)(gbase) + (voff)[_i]), (LAS unsigned*)(lds + (bufoff) + ldsw + _i * 8192), 16, 0, 0); } while (0)
#define PG8_LDA(dst, b, h) do { _Pragma("unroll") for (int m = 0; m < 4; ++m) _Pragma("unroll") for (int k = 0; k < 2; ++k) dst[m][k] = *(const LAS bf16x8*)(lds + PG8_SA(b, h) + aoff + m * 2048 + k * 1024); } while (0)
#define PG8_LDB(dst, b, h) do { _Pragma("unroll") for (int n = 0; n < 2; ++n) _Pragma("unroll") for (int k = 0; k < 2; ++k) dst[n][k] = *(const LAS bf16x8*)(lds + PG8_SB(b, h) + boff + n * 2048 + k * 1024); } while (0)
#define PG8_MMA(ai, bj, At, Bt) do { __builtin_amdgcn_s_setprio(1); _Pragma("unroll") for (int m = 0; m < 4; ++m) _Pragma("unroll") for (int n = 0; n < 2; ++n) _Pragma("unroll") for (int k = 0; k < 2; ++k) \
        acc[ai][bj][m][n] = __builtin_amdgcn_mfma_f32_16x16x32_bf16(Bt[n][k], At[m][k], acc[ai][bj][m][n], 0, 0, 0); __builtin_amdgcn_s_setprio(0); } while (0)
#define PG8_WAIT_V(n) asm volatile("s_waitcnt vmcnt(" #n ")" ::: "memory")
#define PG8_WAIT_L(n) asm volatile("s_waitcnt lgkmcnt(" #n ")" ::: "memory")
#define PG8_BAR __builtin_amdgcn_s_barrier()
#define PG8_SCHED __builtin_amdgcn_sched_barrier(0)
#define PG8_ACOL(u) (BR ? (((u).pn >> 2) == 0 ? 512 : (((u).pn >> 2) == 1 ? 3072 : 3584)) : 0)
    Unit cur, nxt; int ui = 0;
    if (!S.next(0, cur)) return;
    if (stagger > 0) { const unsigned cls = ((unsigned)S.c >> 3) & 3u; const unsigned long long t0 = __builtin_amdgcn_s_memrealtime();
        while (__builtin_amdgcn_s_memrealtime() - t0 < (unsigned long long)(cls * (unsigned)stagger)) __builtin_amdgcn_s_sleep(8); }
    f32x4 acc[2][2][4][2];
#pragma unroll
    for (int a = 0; a < 2; ++a)
#pragma unroll
        for (int b = 0; b < 2; ++b)
#pragma unroll
            for (int m = 0; m < 4; ++m)
#pragma unroll
                for (int n = 0; n < 2; ++n) acc[a][b][m][n] = (f32x4){0.f, 0.f, 0.f, 0.f};
    bf16x8 At[4][2], B0[2][2], B1[2][2];
    const char* cA = (const char*)g.A + (size_t)cur.pm * tA + (size_t)PG8_ACOL(cur) * 2; const char* cB = (const char*)g.Bt + (size_t)cur.pn * tB;
    PG8_STAGE(PG8_SB(0, 0), cB, voffB); PG8_STAGE(PG8_SB(0, 1), cB + hB, voffB); PG8_STAGE(PG8_SA(0, 0), cA, voffA); PG8_STAGE(PG8_SA(0, 1), cA + hA, voffA);
    if (wr == 1) PG8_BAR;
    PG8_WAIT_V(2); PG8_BAR;
    PG8_STAGE(PG8_SB(1, 0), cB + kstep, voffB); PG8_STAGE(PG8_SA(1, 0), cA + kstepA, voffA); PG8_STAGE(PG8_SB(1, 1), cB + hB + kstep, voffB);
    PG8_WAIT_V(6); PG8_BAR;
    for (;;) {
        const bool has_next = S.next(ui + 1, nxt);
        const char* nA = has_next ? (const char*)g.A + (size_t)nxt.pm * tA + (size_t)PG8_ACOL(nxt) * 2 : cA; const char* nB = has_next ? (const char*)g.Bt + (size_t)nxt.pn * tB : cB;
        for (int t = 0; t < nt; t += 2) {
            const bool last = (t == nt - 2);
            const char* a1 = cA + (size_t)(t + 1) * kstepA;
            const char* a2 = last ? nA : cA + (size_t)(t + 2) * kstepA; const char* b2 = last ? nB : cB + (size_t)(t + 2) * kstep;
            const char* a3 = a2 + kstepA; const char* b3 = b2 + kstep;
            PG8_LDB(B0, 0, 0); PG8_LDB(B1, 0, 1); PG8_SCHED; PG8_LDA(At, 0, 0); PG8_STAGE(PG8_SA(1, 1), a1 + hA, voffA);
            PG8_WAIT_V(8); PG8_WAIT_L(0); PG8_BAR; PG8_MMA(0, 0, At, B0); PG8_MMA(0, 1, At, B1); PG8_BAR; PG8_SCHED;
            PG8_LDA(At, 0, 1); PG8_STAGE(PG8_SB(0, 0), b2, voffB); PG8_STAGE(PG8_SB(0, 1), b2 + hB, voffB); PG8_STAGE(PG8_SA(0, 0), a2, voffA);
            PG8_WAIT_V(8); PG8_WAIT_L(0); PG8_BAR; PG8_MMA(1, 0, At, B0); PG8_MMA(1, 1, At, B1); PG8_BAR; PG8_SCHED;
            PG8_LDB(B0, 1, 0); PG8_LDB(B1, 1, 1); PG8_SCHED; PG8_LDA(At, 1, 0); PG8_STAGE(PG8_SA(0, 1), a2 + hA, voffA);
            PG8_WAIT_V(8); PG8_WAIT_L(0); PG8_BAR; PG8_MMA(0, 0, At, B0); PG8_MMA(0, 1, At, B1); PG8_BAR; PG8_SCHED;
            PG8_LDA(At, 1, 1); PG8_STAGE(PG8_SB(1, 0), b3, voffB); PG8_STAGE(PG8_SB(1, 1), b3 + hB, voffB); PG8_STAGE(PG8_SA(1, 0), a3, voffA);
            PG8_WAIT_V(8); PG8_WAIT_L(0); PG8_BAR; PG8_MMA(1, 0, At, B0); PG8_MMA(1, 1, At, B1); PG8_BAR; PG8_SCHED;
        }
        if (wr == 0) PG8_BAR;
        E(acc, cur, wr, wc, fr, fq);
        if (!has_next) break;
#pragma unroll
        for (int a = 0; a < 2; ++a)
#pragma unroll
            for (int b = 0; b < 2; ++b)
#pragma unroll
                for (int m = 0; m < 4; ++m)
#pragma unroll
                    for (int n = 0; n < 2; ++n) acc[a][b][m][n] = (f32x4){0.f, 0.f, 0.f, 0.f};
        cur = nxt; cA = nA; cB = nB; ++ui;
        if (wr == 1) PG8_BAR;
    }
    PG8_WAIT_V(0);
    PG8_BAR;
#undef PG8_SA
#undef PG8_SB
#undef PG8_STAGE
#undef PG8_LDA
#undef PG8_LDB
#undef PG8_MMA
#undef PG8_WAIT_V
#undef PG8_WAIT_L
#undef PG8_BAR
#undef PG8_SCHED
#undef PG8_ACOL
}

struct EpiGateUp {
    bf16_t* H; const float* ssq; int dry;
    DI void operator()(const f32x4 (&acc)[2][2][4][2], const Unit& u, int wr, int wc, int fr, int fq) const {
        const int lane = fr + 16 * fq;
        const float rs0 = row_rstd(ssq, u.pm * BM + wr * 64 + lane), rs1 = row_rstd(ssq, u.pm * BM + HALF + wr * 64 + lane);
        asm volatile("" ::: "memory");
#pragma unroll
        for (int ai = 0; ai < 2; ++ai)
#pragma unroll
            for (int m = 0; m < 4; ++m) {
                const int r = u.pm * BM + ai * HALF + wr * 64 + m * 16 + fr; const float rs = __shfl(ai ? rs1 : rs0, m * 16 + fr);
                float hv[8];
#pragma unroll
                for (int n = 0; n < 2; ++n)
#pragma unroll
                    for (int j = 0; j < 4; ++j) { const float gt = acc[ai][0][m][n][j] * rs, up = acc[ai][1][m][n][j] * rs; hv[4 * n + j] = gt * sigm(gt) * up; }
                u32x4 w; w.x = pk2(hv[0], hv[1]); w.y = pk2(hv[2], hv[3]); w.z = pk2(hv[4], hv[5]); w.w = pk2(hv[6], hv[7]);
                if (!dry) st16(H + ((size_t)(u.pm * (DFF / 64) + 2 * u.pn + (wc >> 1)) * 256 + (ai * HALF + wr * 64 + m * 16 + fr)) * 64 + 32 * (wc & 1) + 8 * fq, w);
            }
    }
};
struct EpiResid {
    const float* xin32; float* xout32; bf16_t* xb; float* ssq; float alpha; int row0; int dry; bf16_t* xbo; float* ssqo;
    DI void tail(const f32x4& v0, const f32x4& v1, size_t off, float& sq) const {
        if (!dry) {
            if (xout32) { *(f32x4*)(xout32 + off) = v0; *(f32x4*)(xout32 + off + 4) = v1; }
            else { u32x4 w; w.x = pk2(v0[0], v0[1]); w.y = pk2(v0[2], v0[3]); w.z = pk2(v1[0], v1[1]); w.w = pk2(v1[2], v1[3]); st16(xbo + off, w); }
        }
        sq += (v0[0] * v0[0] + v0[1] * v0[1]) + (v0[2] * v0[2] + v0[3] * v0[3]) + (v1[0] * v1[0] + v1[1] * v1[1]) + (v1[2] * v1[2] + v1[3] * v1[3]);
    }
    DI void operator()(const f32x4 (&acc)[2][2][4][2], const Unit& u, int wr, int wc, int fr, int fq) const {
        if (xin32) {
#pragma unroll
            for (int ai = 0; ai < 2; ++ai) {
                f32x4 v[4][2][2];
#pragma unroll
                for (int m = 0; m < 4; ++m)
#pragma unroll
                    for (int bj = 0; bj < 2; ++bj) { const size_t off = (size_t)(row0 + u.pm * BM + ai * HALF + wr * 64 + m * 16 + fr) * DM + u.pn * BM + wc * 64 + bj * 32 + 8 * fq;
                        v[m][bj][0] = *(const f32x4*)(xin32 + off); v[m][bj][1] = *(const f32x4*)(xin32 + off + 4); }
                asm volatile("" ::: "memory");
#pragma unroll
                for (int m = 0; m < 4; ++m) { const int r = row0 + u.pm * BM + ai * HALF + wr * 64 + m * 16 + fr; float sq = 0.f;
#pragma unroll
                    for (int bj = 0; bj < 2; ++bj) tail(v[m][bj][0] + acc[ai][bj][m][0] * alpha, v[m][bj][1] + acc[ai][bj][m][1] * alpha, (size_t)r * DM + u.pn * BM + wc * 64 + bj * 32 + 8 * fq, sq);
                    sq += __shfl_xor(sq, 16); sq += __shfl_xor(sq, 32);
                    if (fq == 0 && !dry) ssqo[(size_t)r * 16 + u.pn * 4 + wc] = sq; }
                asm volatile("" ::: "memory");
            }
        } else {
            u32x4 x0[4][2], x1[4][2];
#pragma unroll
            for (int m = 0; m < 4; ++m)
#pragma unroll
                for (int bj = 0; bj < 2; ++bj) x0[m][bj] = *(const u32x4*)(xb + (size_t)(row0 + u.pm * BM + wr * 64 + m * 16 + fr) * DM + u.pn * BM + wc * 64 + bj * 32 + 8 * fq);
            asm volatile("" ::: "memory");
#pragma unroll
            for (int m = 0; m < 4; ++m) { const int r = row0 + u.pm * BM + wr * 64 + m * 16 + fr; float sq = 0.f;
#pragma unroll
                for (int bj = 0; bj < 2; ++bj) x1[m][bj] = *(const u32x4*)(xb + (size_t)(r + HALF) * DM + u.pn * BM + wc * 64 + bj * 32 + 8 * fq);
                asm volatile("" ::: "memory");
#pragma unroll
                for (int bj = 0; bj < 2; ++bj) { const u32x4 t = x0[m][bj];
                    tail((f32x4){bflo(t.x), bfhi(t.x), bflo(t.y), bfhi(t.y)} + acc[0][bj][m][0] * alpha, (f32x4){bflo(t.z), bfhi(t.z), bflo(t.w), bfhi(t.w)} + acc[0][bj][m][1] * alpha,
                         (size_t)r * DM + u.pn * BM + wc * 64 + bj * 32 + 8 * fq, sq); }
                sq += __shfl_xor(sq, 16); sq += __shfl_xor(sq, 32);
                if (fq == 0 && !dry) ssqo[(size_t)r * 16 + u.pn * 4 + wc] = sq;
                asm volatile("" ::: "memory"); }
#pragma unroll
            for (int m = 0; m < 4; ++m) { const int r = row0 + u.pm * BM + HALF + wr * 64 + m * 16 + fr; float sq = 0.f;
#pragma unroll
                for (int bj = 0; bj < 2; ++bj) { const u32x4 t = x1[m][bj];
                    tail((f32x4){bflo(t.x), bfhi(t.x), bflo(t.y), bfhi(t.y)} + acc[1][bj][m][0] * alpha, (f32x4){bflo(t.z), bfhi(t.z), bflo(t.w), bfhi(t.w)} + acc[1][bj][m][1] * alpha,
                         (size_t)r * DM + u.pn * BM + wc * 64 + bj * 32 + 8 * fq, sq); }
                sq += __shfl_xor(sq, 16); sq += __shfl_xor(sq, 32);
                if (fq == 0 && !dry) ssqo[(size_t)r * 16 + u.pn * 4 + wc] = sq; }
        }
    }
};
struct EpiInProj {
    bf16_t* cols; unsigned char* G; const float* ssq; const float* cosT; const float* sinT; int row0; int dry;
    DI void operator()(const f32x4 (&acc)[2][2][4][2], const Unit& u, int wr, int wc, int fr, int fq) const {
        const int pn = u.pn, lane = fr + 16 * fq;
        const float rs0 = row_rstd(ssq, row0 + u.pm * BM + wr * 64 + lane), rs1 = row_rstd(ssq, row0 + u.pm * BM + HALF + wr * 64 + lane);
        asm volatile("" ::: "memory");
        if (pn < 2 || pn == 4 || pn == 5) {
            const int zt = pn < 2 ? pn : pn - 2;
#pragma unroll
            for (int ai = 0; ai < 2; ++ai)
#pragma unroll
                for (int m = 0; m < 4; ++m) {
                    const int rl = u.pm * BM + ai * HALF + wr * 64 + m * 16 + fr; const float rs = __shfl(ai ? rs1 : rs0, m * 16 + fr), rs2 = rs * rs;
                    const f32x4 z0 = acc[ai][0][m][0] * acc[ai][1][m][0] * rs2, z1 = acc[ai][0][m][1] * acc[ai][1][m][1] * rs2;
                    u32x4 w; w.x = pk2(z0[0], z0[1]); w.y = pk2(z0[2], z0[3]); w.z = pk2(z1[0], z1[1]); w.w = pk2(z1[2], z1[3]);
                    if (!dry) st16(cols + (size_t)rl * INC + zt * 128 + wc * 32 + 8 * fq, w);
                }
            return;
        }
#pragma unroll
        for (int ai = 0; ai < 2; ++ai)
#pragma unroll
            for (int m = 0; m < 4; ++m) {
                const int rl = u.pm * BM + ai * HALF + wr * 64 + m * 16 + fr; const float rs = __shfl(ai ? rs1 : rs0, m * 16 + fr);
                if (pn >= 20) {
#pragma unroll
                    for (int bj = 0; bj < 2; ++bj) { const f32x4 a0 = acc[ai][bj][m][0] * rs, a1 = acc[ai][bj][m][1] * rs;
                        u32x2 w; w.x = pkq4(sigm(a0[0]), sigm(a0[1]), sigm(a0[2]), sigm(a0[3])); w.y = pkq4(sigm(a1[0]), sigm(a1[1]), sigm(a1[2]), sigm(a1[3]));
                        if (!dry) *(u32x2*)(G + (size_t)rl * GZ + (pn - 20) * BM + wc * 64 + bj * 32 + 8 * fq) = w; }
                } else if (pn >= 6 && pn < 10) {
                    const int pos = (row0 + rl) & (SEQ - 1), hh = wc >> 1, dd0 = 32 * (wc & 1) + 8 * fq;
                    const f32x4 c0 = *(const f32x4*)(cosT + pos * 64 + dd0), c1 = *(const f32x4*)(cosT + pos * 64 + dd0 + 4);
                    const f32x4 s0 = *(const f32x4*)(sinT + pos * 64 + dd0), s1 = *(const f32x4*)(sinT + pos * 64 + dd0 + 4);
                    const f32x4 x10 = acc[ai][0][m][0] * rs, x11 = acc[ai][0][m][1] * rs, x20 = acc[ai][1][m][0] * rs, x21 = acc[ai][1][m][1] * rs;
                    const f32x4 y10 = x10 * c0 - x20 * s0, y11 = x11 * c1 - x21 * s1, y20 = x10 * s0 + x20 * c0, y21 = x11 * s1 + x21 * c1;
                    u32x4 w1, w2; w1.x = pk2(y10[0], y10[1]); w1.y = pk2(y10[2], y10[3]); w1.z = pk2(y11[0], y11[1]); w1.w = pk2(y11[2], y11[3]);
                    w2.x = pk2(y20[0], y20[1]); w2.y = pk2(y20[2], y20[3]); w2.z = pk2(y21[0], y21[1]); w2.w = pk2(y21[2], y21[3]);
                    bf16_t* p = cols + (size_t)rl * INC + pn * BM + hh * 128 + dd0;
                    if (!dry) { st16(p, w1); st16(p + 64, w2); }
                } else {
#pragma unroll
                    for (int bj = 0; bj < 2; ++bj) { const f32x4 a0 = acc[ai][bj][m][0] * rs, a1 = acc[ai][bj][m][1] * rs;
                        u32x4 w; w.x = pk2(a0[0], a0[1]); w.y = pk2(a0[2], a0[3]); w.z = pk2(a1[0], a1[1]); w.w = pk2(a1[2], a1[3]);
                        if (!dry) st16(cols + (size_t)rl * INC + pn * BM + wc * 64 + bj * 32 + 8 * fq, w); }
                }
            }
    }
};
struct EpiBranch {
    const unsigned char* Gt; bf16_t* Mb; int dry;
    DI void comb(const f32x4& a0, const f32x4& a1, const u32x2& g, const u32x4& mm, bf16_t* dst) const {
        u32x4 w; w.x = pk2(bflo(mm.x) + ub(g.x, 0) * a0[0], bfhi(mm.x) + ub(g.x, 1) * a0[1]); w.y = pk2(bflo(mm.y) + ub(g.x, 2) * a0[2], bfhi(mm.y) + ub(g.x, 3) * a0[3]);
        w.z = pk2(bflo(mm.z) + ub(g.y, 0) * a1[0], bfhi(mm.z) + ub(g.y, 1) * a1[1]); w.w = pk2(bflo(mm.w) + ub(g.y, 2) * a1[2], bfhi(mm.w) + ub(g.y, 3) * a1[3]);
        if (!dry) st16(dst, w);
    }
    DI void operator()(const f32x4 (&acc)[2][2][4][2], const Unit& u, int wr, int wc, int fr, int fq) const {
        const int br = u.pn >> 2, pc = u.pn & 3;
        u32x2 g0[4][2], g1[4][2]; u32x4 m0[4][2], m1[4][2];
#pragma unroll
        for (int m = 0; m < 4; ++m)
#pragma unroll
            for (int bj = 0; bj < 2; ++bj) { const int rl = u.pm * BM + wr * 64 + m * 16 + fr;
                g0[m][bj] = *(const u32x2*)(Gt + (size_t)rl * GZ + u.pn * BM + wc * 64 + bj * 32 + 8 * fq);
                if (br) m0[m][bj] = *(const u32x4*)(Mb + (size_t)rl * DM + pc * BM + wc * 64 + bj * 32 + 8 * fq); else m0[m][bj] = (u32x4){0u, 0u, 0u, 0u}; }
        asm volatile("" ::: "memory");
#pragma unroll
        for (int m = 0; m < 4; ++m) {
            const int rl = u.pm * BM + wr * 64 + m * 16 + fr;
#pragma unroll
            for (int bj = 0; bj < 2; ++bj) {
                g1[m][bj] = *(const u32x2*)(Gt + (size_t)(rl + HALF) * GZ + u.pn * BM + wc * 64 + bj * 32 + 8 * fq);
                if (br) m1[m][bj] = *(const u32x4*)(Mb + (size_t)(rl + HALF) * DM + pc * BM + wc * 64 + bj * 32 + 8 * fq); else m1[m][bj] = (u32x4){0u, 0u, 0u, 0u}; }
            asm volatile("" ::: "memory");
#pragma unroll
            for (int bj = 0; bj < 2; ++bj) comb(acc[0][bj][m][0], acc[0][bj][m][1], g0[m][bj], m0[m][bj], Mb + (size_t)rl * DM + pc * BM + wc * 64 + bj * 32 + 8 * fq);
            asm volatile("" ::: "memory");
        }
#pragma unroll
        for (int m = 0; m < 4; ++m) { const int rl = u.pm * BM + HALF + wr * 64 + m * 16 + fr;
#pragma unroll
            for (int bj = 0; bj < 2; ++bj) comb(acc[1][bj][m][0], acc[1][bj][m][1], g1[m][bj], m1[m][bj], Mb + (size_t)rl * DM + pc * BM + wc * 64 + bj * 32 + 8 * fq); }
    }
};
}

struct Params { const float* in[17]; float* out; unsigned char* ws; int lo, hi; float invf[64]; };
enum { I_X = 0, I_F1N, I_F1G, I_F1U, I_F1D, I_MN, I_WIN, I_CW, I_RB, I_WB, I_WMG, I_WO, I_F2N, I_F2G, I_F2U, I_F2D, I_FN };

struct WJob { const float* src; int ld, K, N; const float* gain; bf16_t* dst; int Kdst, koff, mode, rowoff; float scale; };
DI WJob get_job(const Params& P, int l, int j) {
    WJob w; unsigned char* wl = P.ws + WS_WT + (size_t)l * WLAYER;
    w.gain = nullptr; w.koff = 0; w.mode = 0; w.rowoff = 0; w.scale = 1.f;
    if (j == 0 || j == 1 || j == 11 || j == 12) {
        const bool second = j >= 11; const bool up = (j == 1 || j == 12);
        w.src = P.in[second ? (up ? I_F2U : I_F2G) : (up ? I_F1U : I_F1G)] + (size_t)l * DM * DFF; w.ld = DFF; w.K = DM; w.N = DFF;
        w.gain = P.in[second ? I_F2N : I_F1N] + l * DM; w.dst = (bf16_t*)(wl + (second ? WO6 : WO1)); w.Kdst = DM; w.mode = 1; w.rowoff = up ? 128 : 0;
    } else if (j == 2 || j == 13) {
        w.src = P.in[j == 2 ? I_F1D : I_F2D] + (size_t)l * DFF * DM; w.ld = DM; w.K = DFF; w.N = DM; w.dst = (bf16_t*)(wl + (j == 2 ? WO2 : WO7)); w.Kdst = DFF;
    } else if (j == 3) {
        w.src = P.in[I_WIN] + (size_t)l * DM * INC; w.ld = INC; w.K = DM; w.N = INC; w.gain = P.in[I_MN] + l * DM; w.dst = (bf16_t*)(wl + WO3); w.Kdst = DM; w.mode = 2;
    } else if (j >= 4 && j <= 6) {
        const int i = j - 4; w.src = P.in[I_WMG] + (size_t)(l * 3 + i) * DM * DM; w.ld = DM; w.K = DM; w.N = DM; w.gain = P.in[I_MN] + l * DM; w.dst = (bf16_t*)(wl + WO3); w.Kdst = DM; w.rowoff = INC + i * DM;
    } else if (j >= 7 && j <= 9) {
        const int i = j - 7; w.src = P.in[I_WB] + (size_t)(l * 3 + i) * 512 * DM; w.ld = DM; w.K = 512; w.N = DM; w.dst = (bf16_t*)(wl + WO4); w.Kdst = 512; w.rowoff = i * DM; w.scale = 1.f / 255.f;
    } else {
        w.src = P.in[I_WO] + (size_t)l * DM * DM; w.ld = DM; w.K = DM; w.N = DM; w.dst = (bf16_t*)(wl + WO5); w.Kdst = DM;
    }
    return w;
}
DI void wt_tile(const WJob& w, int tile, LAS float* scr, int lane) {
    const int nbn = w.N / 32, kb = tile / nbn, nb = tile % nbn, k0 = kb * 64, n0 = nb * 32;
    float scale = w.scale;
    if (w.mode == 2) { if (n0 >= 1536 && n0 < 2048) scale = 0.08838834764831845f; else if (n0 >= 3584 && n0 < 4096) scale = 0.125f * LOG2E; }
    f32x4 v[8];
#pragma unroll
    for (int i = 0; i < 8; ++i) { const int kk = i * 8 + (lane >> 3); v[i] = *(const f32x4*)(w.src + (size_t)(k0 + kk) * w.ld + n0 + 4 * (lane & 7)); }
#pragma unroll
    for (int i = 0; i < 8; ++i) { const int kk = i * 8 + (lane >> 3); const float gsc = scale * (w.gain ? w.gain[k0 + kk] : 1.f); LAS float* d = scr + kk * 33 + 4 * (lane & 7);
        d[0] = v[i].x * gsc; d[1] = v[i].y * gsc; d[2] = v[i].z * gsc; d[3] = v[i].w * gsc; }
    asm volatile("s_waitcnt lgkmcnt(0)" ::: "memory");
#pragma unroll
    for (int q = 0; q < 4; ++q) { const int item = q * 64 + lane, n = item >> 3, kc = item & 7, ng = n0 + n; int row;
      if (w.mode == 1) row = (ng >> 7) * 256 + ((ng & 127) >> 5) * 64 + (w.rowoff ? 32 : 0) + (ng & 31);
      else if (w.mode == 2 && (ng < 512 || (ng >= 1024 && ng < 1536))) {
          const int cc_ = ng >= 1024, n5 = ng & 511, zt = n5 >> 7, w7 = n5 & 127; row = (zt < 2 ? zt : zt + 2) * 256 + 64 * (w7 >> 5) + 32 * cc_ + (w7 & 31); }
      else if (w.mode == 2 && ng >= 1536 && ng < 2560) { const int pnn = ng >> 8, cl = ng & 255, hh = cl >> 7, d = cl & 127; const int bjj = d >> 6, dd = d & 63; row = pnn * 256 + 64 * (2 * hh + (dd >> 5)) + 32 * bjj + (dd & 31); }
      else row = w.rowoff + ng;
      const LAS float* s = scr + (8 * kc) * 33 + n;
      u32x4 o; o.x = pk2(s[0], s[33]); o.y = pk2(s[2 * 33], s[3 * 33]); o.z = pk2(s[4 * 33], s[5 * 33]); o.w = pk2(s[6 * 33], s[7 * 33]);
      *(u32x4*)(w.dst + (size_t)row * w.Kdst + w.koff + k0 + 8 * kc) = o; }
    asm volatile("s_waitcnt lgkmcnt(0)" ::: "memory");
}
DI float wave_sum(float v) {
#pragma unroll
    for (int o = 1; o < 64; o <<= 1) v += __shfl_xor(v, o);
    return v;
}
DI void prologue(const Params& P, LAS unsigned char* lds) {
    const int tid = otid(), lane = tid & 63, wid = tid >> 6, G = gridDim.x;
    LAS float* scr = (LAS float*)lds + wid * (64 * 33);
    for (int l = 0; l < 2; ++l)
        for (int j = 0; j < 14; ++j) { const WJob w = get_job(P, l, j); const int ntile = (w.K / 64) * (w.N / 32);
            for (int t = obid() * 8 + wid; t < ntile; t += G * 8) wt_tile(w, t, scr, lane); }
    if (blockIdx.x == 0) { unsigned* bw = (unsigned*)(P.ws + WS_BAR); for (int i = tid; i < XCD_BAR_WORDS; i += 512) bw[i] = 0u; }
    const float* x = P.in[I_X]; bf16_t* xb = (bf16_t*)(P.ws + WS_XB); float* ssq = (float*)(P.ws + WS_SSQ);
    for (int row0 = (obid() * 8 + wid) * 4; row0 < MTOK; row0 += G * 32) {
        f32x4 v[4][4];
#pragma unroll
        for (int q = 0; q < 4; ++q)
#pragma unroll
            for (int j = 0; j < 4; ++j) v[q][j] = ((const f32x4*)(x + (size_t)(row0 + q) * DM) + lane)[64 * j];
#pragma unroll
        for (int q = 0; q < 4; ++q) { float sq = 0.f; u32x2* o8 = (u32x2*)(xb + (size_t)(row0 + q) * DM) + lane;
#pragma unroll
            for (int j = 0; j < 4; ++j) { const f32x4 t = v[q][j]; sq += (t.x * t.x + t.y * t.y) + (t.z * t.z + t.w * t.w); u32x2 o; o.x = pk2(t.x, t.y); o.y = pk2(t.z, t.w); o8[64 * j] = o; }
            sq = wave_sum(sq);
            if (lane < 16) ssq[(size_t)(row0 + q) * 16 + lane] = lane == 0 ? sq : 0.f; }
    }
    float* cosT = (float*)(P.ws + WS_COS); float* sinT = (float*)(P.ws + WS_SIN);
    for (int idx = obid() * 512 + tid; idx < SEQ * 64; idx += G * 512) {
        const int pos = idx >> 6, i = idx & 63;
        const float ang = (float)pos * P.invf[i];
        const double rev = (double)ang * 0.15915494309189535; const float fr = (float)(rev - floor(rev));
        cosT[idx] = __builtin_amdgcn_cosf(fr); sinT[idx] = __builtin_amdgcn_sinf(fr);
    }
}

DI void conv_phase(const Params& P, int l, int dry = 0) {
    bf16_t* cols = (bf16_t*)(P.ws + WS_COLS); const float* cw = P.in[I_CW] + l * 3 * 512;
    const int gt = obid() * 512 + otid(), stride = gridDim.x * 512;
    for (int it = gt; it < (HROWS / 8) * 64; it += stride) {
        const int cg8 = it & 63, t0 = (it >> 6) * 8, ch = cg8 * 8;
        float w0[8], w1[8], w2[8], z1[8], z2[8];
#pragma unroll
        for (int e = 0; e < 8; ++e) { w0[e] = cw[ch + e]; w1[e] = cw[512 + ch + e]; w2[e] = cw[1024 + ch + e]; z1[e] = 0.f; z2[e] = 0.f; }
        if ((t0 & (SEQ - 1)) != 0) {
            const u32x4 a1 = *(const u32x4*)(cols + (size_t)(t0 - 1) * INC + ch), a2 = *(const u32x4*)(cols + (size_t)(t0 - 2) * INC + ch);
#pragma unroll
            for (int e = 0; e < 4; ++e) { z1[2 * e] = bflo(a1[e]); z1[2 * e + 1] = bfhi(a1[e]); z2[2 * e] = bflo(a2[e]); z2[2 * e + 1] = bfhi(a2[e]); }
        }
        u32x4 zz[8], bb[8];
#pragma unroll
        for (int q = 0; q < 8; ++q) { const bf16_t* rp = cols + (size_t)(t0 + q) * INC + ch; zz[q] = *(const u32x4*)rp; bb[q] = *(const u32x4*)(rp + 512); }
        asm volatile("" ::: "memory");
#pragma unroll
        for (int q = 0; q < 8; ++q) {
            float y[8];
#pragma unroll
            for (int e = 0; e < 4; ++e) {
                const float za = bflo(zz[q][e]), zb = bfhi(zz[q][e]);
                y[2 * e] = bflo(bb[q][e]) * (w0[2 * e] * z2[2 * e] + w1[2 * e] * z1[2 * e] + w2[2 * e] * za);
                y[2 * e + 1] = bfhi(bb[q][e]) * (w0[2 * e + 1] * z2[2 * e + 1] + w1[2 * e + 1] * z1[2 * e + 1] + w2[2 * e + 1] * zb);
                z2[2 * e] = z1[2 * e]; z2[2 * e + 1] = z1[2 * e + 1]; z1[2 * e] = za; z1[2 * e + 1] = zb;
            }
            u32x4 o; o.x = pk2(y[0], y[1]); o.y = pk2(y[2], y[3]); o.z = pk2(y[4], y[5]); o.w = pk2(y[6], y[7]);
            if (!dry) *(u32x4*)(cols + (size_t)(t0 + q) * INC + 512 + ch) = o;
        }
    }
}

constexpr int RS = 136;
DI float ret_lg(int hh) { return log2f(1.0f - exp2f(-5.0f - (float)hh)); }
DI void ret_local_unit(const Params& P, LAS unsigned char* lds, int unit) {
    const int tid = otid(), wid = tid >> 6, lane = tid & 63, r = lane & 31, h = lane >> 5;
    const int bl = unit >> 6, hh = (unit >> 4) & 3, seg = unit & 15, rowbase = bl * SEQ + seg * 512;
    const bf16_t* cols = (const bf16_t*)(P.ws + WS_COLS); float* T = (float*)(P.ws + WS_T) + (size_t)unit * 16384;
    LAS bf16_t* Ks = (LAS bf16_t*)lds; LAS bf16_t* Vs = Ks + 64 * RS;
    const float lg = ret_lg(hh);
    const int a = wid >> 1, b0 = (wid & 1) * 2, tg = (lane >> 4) & 1, tq = (lane & 15) >> 2, tp = lane & 3;
    f32x16 acc[2];
#pragma unroll
    for (int i = 0; i < 16; ++i) { acc[0][i] = 0.f; acc[1][i] = 0.f; }
    u32x4 pk[2], pv[2];
#pragma unroll
    for (int e = 0; e < 2; ++e) { const int idx = tid + 512 * e, row = idx >> 4, sg = idx & 15; const bf16_t* gp = cols + (size_t)(rowbase + row) * INC + hh * 128 + sg * 8;
        pk[e] = *(const u32x4*)(gp + 2048); pv[e] = *(const u32x4*)(gp + 2560); }
    for (int c = 0; c < 8; ++c) {
        __syncthreads();
#pragma unroll
        for (int e = 0; e < 2; ++e) { const int idx = tid + 512 * e, row = idx >> 4, sg = idx & 15;
            const u32x4 kv = pk[e], vv = pv[e];
            if (c + 1 < 8) { const bf16_t* gp = cols + (size_t)(rowbase + (c + 1) * 64 + row) * INC + hh * 128 + sg * 8; pk[e] = *(const u32x4*)(gp + 2048); pv[e] = *(const u32x4*)(gp + 2560); }
            const float sc = exp2f(lg * (float)(511 - (c * 64 + row)));
            u32x4 ks; ks.x = pk2(bflo(kv.x) * sc, bfhi(kv.x) * sc); ks.y = pk2(bflo(kv.y) * sc, bfhi(kv.y) * sc); ks.z = pk2(bflo(kv.z) * sc, bfhi(kv.z) * sc); ks.w = pk2(bflo(kv.w) * sc, bfhi(kv.w) * sc);
            *(LAS u32x4*)(Ks + row * RS + sg * 8) = ks; *(LAS u32x4*)(Vs + row * RS + sg * 8) = vv; }
        __syncthreads();
#pragma unroll
        for (int s = 0; s < 4; ++s) {
            const int tr0 = (16 * s + 8 * h + tq) * RS + 16 * tg + 4 * tp;
            const bf16x8 af = cat8(trd(Ks + tr0 + 32 * a), trd(Ks + tr0 + 4 * RS + 32 * a));
            const bf16x8 bf0 = cat8(trd(Vs + tr0 + 32 * b0), trd(Vs + tr0 + 4 * RS + 32 * b0)), bf1 = cat8(trd(Vs + tr0 + 32 * (b0 + 1)), trd(Vs + tr0 + 4 * RS + 32 * (b0 + 1)));
            acc[0] = MFMA32(af, bf0, acc[0]); acc[1] = MFMA32(af, bf1, acc[1]);
        }
    }
#pragma unroll
    for (int bb = 0; bb < 2; ++bb)
#pragma unroll
        for (int i = 0; i < 16; ++i) T[(size_t)(32 * a + crow(i, h)) * 128 + 32 * (b0 + bb) + r] = acc[bb][i];
}
DI void ret_scan_unit(const Params& P, LAS unsigned char* lds, int unit, int dry = 0) {
    const int tid = otid(), wid = tid >> 6, lane = tid & 63, r = lane & 31, h = lane >> 5;
    const int bl = unit >> 6, hh = (unit >> 4) & 3, seg = unit & 15, rowbase = bl * SEQ + seg * 512;
    bf16_t* cols = (bf16_t*)(P.ws + WS_COLS); const float* T = (const float*)(P.ws + WS_T);
    LAS bf16_t* Qs = (LAS bf16_t*)lds; LAS bf16_t* Ks = Qs + 64 * RS; LAS bf16_t* Kd = Ks + 64 * RS; LAS bf16_t* Vs = Kd + 64 * RS; LAS bf16_t* St = Vs + 64 * RS;
    LAS float* red = (LAS float*)(St + 128 * RS);
    const float lg = ret_lg(hh);
    const int a = wid >> 1, b0 = (wid & 1) * 2, nt = wid >> 2, vt = wid & 3, tg = (lane >> 4) & 1, tq = (lane & 15) >> 2, tp = lane & 3;
    f32x16 Sacc[2];
#pragma unroll
    for (int i = 0; i < 16; ++i) { Sacc[0][i] = 0.f; Sacc[1][i] = 0.f; }
    for (int p = 0; p < seg; ++p) {
        const float f = exp2f(lg * 512.0f * (float)(seg - 1 - p)); const float* Tp = T + (size_t)(unit - seg + p) * 16384;
#pragma unroll
        for (int bb = 0; bb < 2; ++bb)
#pragma unroll
            for (int i = 0; i < 16; ++i) Sacc[bb][i] += f * Tp[(size_t)(32 * a + crow(i, h)) * 128 + 32 * (b0 + bb) + r];
    }
    const float g64 = exp2f(lg * 64.0f);
    u32x4 pq[2], pk[2], pv[2];
#pragma unroll
    for (int e = 0; e < 2; ++e) { const int idx = tid + 512 * e, row = idx >> 4, sg = idx & 15; const bf16_t* gp = cols + (size_t)(rowbase + row) * INC + hh * 128 + sg * 8;
        pq[e] = *(const u32x4*)(gp + 1536); pk[e] = *(const u32x4*)(gp + 2048); pv[e] = *(const u32x4*)(gp + 2560); }
    __syncthreads();
    for (int c = 0; c < 8; ++c) {
#pragma unroll
        for (int bb = 0; bb < 2; ++bb)
#pragma unroll
            for (int g4 = 0; g4 < 4; ++g4) { u32x2 w; w.x = pk2(Sacc[bb][4 * g4], Sacc[bb][4 * g4 + 1]); w.y = pk2(Sacc[bb][4 * g4 + 2], Sacc[bb][4 * g4 + 3]);
                *(LAS u32x2*)(St + (32 * (b0 + bb) + r) * RS + 32 * a + 8 * g4 + 4 * h) = w; }
#pragma unroll
        for (int e = 0; e < 2; ++e) { const int idx = tid + 512 * e, row = idx >> 4, sg = idx & 15;
            const u32x4 qv = pq[e], kv = pk[e], vv = pv[e];
            const float sc = ex2(lg * (float)(63 - row));
            u32x4 ks; ks.x = pk2(bflo(kv.x) * sc, bfhi(kv.x) * sc); ks.y = pk2(bflo(kv.y) * sc, bfhi(kv.y) * sc); ks.z = pk2(bflo(kv.z) * sc, bfhi(kv.z) * sc); ks.w = pk2(bflo(kv.w) * sc, bfhi(kv.w) * sc);
            *(LAS u32x4*)(Qs + row * RS + sg * 8) = qv; *(LAS u32x4*)(Ks + row * RS + sg * 8) = kv; *(LAS u32x4*)(Kd + row * RS + sg * 8) = ks; *(LAS u32x4*)(Vs + row * RS + sg * 8) = vv; }
        __syncthreads();
        if (c + 1 < 8) {
#pragma unroll
            for (int e = 0; e < 2; ++e) { const int idx = tid + 512 * e, row = idx >> 4, sg = idx & 15; const bf16_t* gp = cols + (size_t)(rowbase + (c + 1) * 64 + row) * INC + hh * 128 + sg * 8;
                pq[e] = *(const u32x4*)(gp + 1536); pk[e] = *(const u32x4*)(gp + 2048); pv[e] = *(const u32x4*)(gp + 2560); }
        }
        f32x16 pT[2];
#pragma unroll
        for (int i = 0; i < 16; ++i) { pT[0][i] = 0.f; pT[1][i] = 0.f; }
#pragma unroll
        for (int ks = 0; ks < 8; ++ks) {
            const bf16x8 qf = *(const LAS bf16x8*)(Qs + (32 * nt + r) * RS + 16 * ks + 8 * h);
            const bf16x8 k0 = *(const LAS bf16x8*)(Ks + r * RS + 16 * ks + 8 * h), k1 = *(const LAS bf16x8*)(Ks + (32 + r) * RS + 16 * ks + 8 * h);
            pT[0] = MFMA32(k0, qf, pT[0]); pT[1] = MFMA32(k1, qf, pT[1]);
        }
        const int nq = 32 * nt + r;
#pragma unroll
        for (int mt = 0; mt < 2; ++mt)
#pragma unroll
            for (int i = 0; i < 16; ++i) { const int mm = 32 * mt + crow(i, h); const int dd = nq > mm ? nq - mm : mm - nq; pT[mt][i] *= ex2(lg * (float)dd); }
        f32x16 O1, O2;
#pragma unroll
        for (int i = 0; i < 16; ++i) { O1[i] = 0.f; O2[i] = 0.f; }
#pragma unroll
        for (int mt = 0; mt < 2; ++mt)
#pragma unroll
            for (int s = 0; s < 2; ++s) {
                const bf16x8 af = pack8(pT[mt][8 * s], pT[mt][8 * s + 1], pT[mt][8 * s + 2], pT[mt][8 * s + 3], pT[mt][8 * s + 4], pT[mt][8 * s + 5], pT[mt][8 * s + 6], pT[mt][8 * s + 7]);
                const int tr0 = (32 * mt + 16 * s + 4 * h + tq) * RS + 32 * vt + 16 * tg + 4 * tp;
                const bf16x8 bf = cat8(trd(Vs + tr0), trd(Vs + tr0 + 8 * RS));
                O1 = MFMA32(af, bf, O1);
            }
#pragma unroll
        for (int ks = 0; ks < 8; ++ks) {
            const bf16x8 qf = *(const LAS bf16x8*)(Qs + (32 * nt + r) * RS + 16 * ks + 8 * h);
            const bf16x8 sf = *(const LAS bf16x8*)(St + (32 * vt + r) * RS + 16 * ks + 8 * h);
            O2 = MFMA32(qf, sf, O2);
        }
#pragma unroll
        for (int i = 0; i < 16; ++i) { const int n = 32 * nt + crow(i, h); O1[i] += ex2(lg * (float)(n + 1)) * O2[i]; }
#pragma unroll
        for (int i = 0; i < 16; ++i) { float v = O1[i] * O1[i];
            v += __builtin_bit_cast(float, __builtin_amdgcn_update_dpp(0, __builtin_bit_cast(int, v), 0xB1, 0xf, 0xf, false));
            v += __builtin_bit_cast(float, __builtin_amdgcn_update_dpp(0, __builtin_bit_cast(int, v), 0x4E, 0xf, 0xf, false));
            v += __builtin_bit_cast(float, __builtin_amdgcn_update_dpp(0, __builtin_bit_cast(int, v), 0x141, 0xf, 0xf, false));
            v += __builtin_bit_cast(float, __builtin_amdgcn_update_dpp(0, __builtin_bit_cast(int, v), 0x140, 0xf, 0xf, false));
            v += __shfl_xor(v, 16);
            if (r == 0) red[(32 * nt + crow(i, h)) * 4 + vt] = v; }
        bf16_t gq[16];
#pragma unroll
        for (int i = 0; i < 16; ++i) gq[i] = cols[(size_t)(rowbase + c * 64 + 32 * nt + crow(i, h)) * INC + 3072 + hh * 128 + 32 * vt + r];
#pragma unroll
        for (int i = 0; i < 16; ++i) { Sacc[0][i] *= g64; Sacc[1][i] *= g64; }
#pragma unroll
        for (int s = 0; s < 4; ++s) {
            const int tr0 = (16 * s + 8 * h + tq) * RS + 16 * tg + 4 * tp;
            const bf16x8 af = cat8(trd(Kd + tr0 + 32 * a), trd(Kd + tr0 + 4 * RS + 32 * a));
            const bf16x8 bf0 = cat8(trd(Vs + tr0 + 32 * b0), trd(Vs + tr0 + 4 * RS + 32 * b0)), bf1 = cat8(trd(Vs + tr0 + 32 * (b0 + 1)), trd(Vs + tr0 + 4 * RS + 32 * (b0 + 1)));
            Sacc[0] = MFMA32(af, bf0, Sacc[0]); Sacc[1] = MFMA32(af, bf1, Sacc[1]);
        }
        __syncthreads();
#pragma unroll
        for (int i = 0; i < 16; ++i) { const int n = 32 * nt + crow(i, h); const f32x4 q = *(const LAS f32x4*)(red + n * 4);
            const float rn = __builtin_amdgcn_rsqf(((q.x + q.y) + (q.z + q.w)) * (1.f / 128.f) + EPS);
            bf16_t* gp = cols + (size_t)(rowbase + c * 64 + n) * INC + 3072 + hh * 128 + 32 * vt + r;
            const float gv = bf2f(gq[i]); const bf16_t yv = f2bf(gv * sigm(gv) * O1[i] * rn); if (!dry) *gp = yv; }
    }
}

constexpr int ATT_BIAS_OFF = 0, ATT_SCR_OFF = 8704, ATT_T_OFF = 10240, ATT_WAVE_BYTES = 16384;
DI void att_dma_tile(const bf16_t* gsrc, LAS unsigned char* tile, int lane) {
#pragma unroll
    for (int e = 0; e < 8; ++e) { const int row = e * 8 + (lane >> 3), pos = lane & 7;
        __builtin_amdgcn_global_load_lds((const unsigned*)(gsrc + (size_t)row * INC + ((pos ^ (row & 7)) << 3)), (LAS unsigned*)(tile + e * 1024), 16, 0, 0); }
}
DI void attn_unit(bf16_t* cols, LAS unsigned char* lds, int wid, int lane, int bl, int hh, int c, int dry) {
    const int r = lane & 31, h = lane >> 5, tg = (lane >> 4) & 1, tq = (lane & 15) >> 2, tp = lane & 3;
    const LAS float* bt = (const LAS float*)(lds + ATT_BIAS_OFF) + hh * 264;
    LAS float* scr = (LAS float*)(lds + ATT_SCR_OFF) + wid * 32;
    LAS unsigned char* Kt = lds + ATT_T_OFF + wid * ATT_WAVE_BYTES; LAS unsigned char* Vt = Kt + 8192;
    const int seqbase = bl * SEQ, tq0 = seqbase + c * 64;
    const int j0 = c >= 8 ? 0 : 8 - c;
    { const bf16_t* kb = cols + (size_t)(seqbase + (c - 8 + j0) * 64) * INC + 4096 + hh * 64; att_dma_tile(kb, Kt, lane); att_dma_tile(kb + 512, Vt, lane); }
    bf16x8 qf[2][4];
#pragma unroll
    for (int qt = 0; qt < 2; ++qt)
#pragma unroll
        for (int d0 = 0; d0 < 4; ++d0) qf[qt][d0] = *(const bf16x8*)(cols + (size_t)(tq0 + 32 * qt + r) * INC + 3584 + hh * 64 + 16 * d0 + 8 * h);
    float mrow[2] = {-1e30f, -1e30f}, lsum[2] = {0.f, 0.f};
    f32x16 O[2][2];
#pragma unroll
    for (int i = 0; i < 16; ++i) { O[0][0][i] = 0.f; O[0][1][i] = 0.f; O[1][0][i] = 0.f; O[1][1][i] = 0.f; }
    for (int j = j0; j <= 8; ++j) {
        const bf16_t* kbn = cols + (size_t)(seqbase + (c - 7 + j) * 64) * INC + 4096 + hh * 64;
        asm volatile("s_waitcnt vmcnt(8)" ::: "memory");
        bf16x8 kf[2][4];
#pragma unroll
        for (int t = 0; t < 2; ++t)
#pragma unroll
            for (int d0 = 0; d0 < 4; ++d0) { const int row = 32 * t + r, ch = 2 * d0 + h; kf[t][d0] = *(const LAS bf16x8*)(Kt + row * 128 + ((ch ^ (row & 7)) << 4)); }
        asm volatile("s_waitcnt lgkmcnt(0)" ::: "memory");
        if (j < 8) att_dma_tile(kbn, Kt, lane);
        asm volatile("" ::: "memory");
        bf16x8 pf[2][4];
#pragma unroll
        for (int qt = 0; qt < 2; ++qt) {
            const int n = 32 * qt + r;
            f32x16 sT[2];
            { const float b = j <= 5 ? bt[256] : 0.f;
#pragma unroll
              for (int i = 0; i < 16; ++i) { sT[0][i] = b; sT[1][i] = b; } }
#pragma unroll
            for (int d0 = 0; d0 < 4; ++d0) { sT[0] = MFMA32(kf[0][d0], qf[qt][d0], sT[0]); sT[1] = MFMA32(kf[1][d0], qf[qt][d0], sT[1]); }
            if (j > 5) {
#pragma unroll
                for (int t = 0; t < 2; ++t)
#pragma unroll
                    for (int i = 0; i < 16; ++i) { const int mm = 32 * t + crow(i, h); int dist = 64 * (8 - j) + n - mm; dist = dist > 128 ? 128 : dist; sT[t][i] += bt[dist + 128]; }
            }
            float mx = fmaxf(sT[0][0], sT[1][0]);
#pragma unroll
            for (int i = 1; i < 16; ++i) mx = fmaxf(mx, fmaxf(sT[0][i], sT[1][i]));
            mx = fmaxf(mx, __shfl_xor(mx, 32));
            if (__any(mx > mrow[qt])) {
                const float mnew = fmaxf(mrow[qt], mx), alpha = ex2(mrow[qt] - mnew); mrow[qt] = mnew; lsum[qt] *= alpha;
                if (h == 0) scr[r] = alpha;
                asm volatile("s_waitcnt lgkmcnt(0)" ::: "memory");
#pragma unroll
                for (int g4 = 0; g4 < 4; ++g4) { const f32x4 a4 = *(const LAS f32x4*)(scr + 8 * g4 + 4 * h);
#pragma unroll
                    for (int e = 0; e < 4; ++e) { O[qt][0][4 * g4 + e] *= a4[e]; O[qt][1][4 * g4 + e] *= a4[e]; } }
                asm volatile("s_waitcnt lgkmcnt(0)" ::: "memory");
            }
            float ls = 0.f;
#pragma unroll
            for (int t = 0; t < 2; ++t)
#pragma unroll
                for (int i = 0; i < 16; ++i) { const float p = ex2(sT[t][i] - mrow[qt]); sT[t][i] = p; ls += p; }
            lsum[qt] += ls;
#pragma unroll
            for (int t = 0; t < 2; ++t)
#pragma unroll
                for (int s2 = 0; s2 < 2; ++s2)
                    pf[qt][2 * t + s2] = pack8(sT[t][8 * s2], sT[t][8 * s2 + 1], sT[t][8 * s2 + 2], sT[t][8 * s2 + 3], sT[t][8 * s2 + 4], sT[t][8 * s2 + 5], sT[t][8 * s2 + 6], sT[t][8 * s2 + 7]);
        }
        if (j < 8) asm volatile("s_waitcnt vmcnt(8)" ::: "memory"); else asm volatile("s_waitcnt vmcnt(0)" ::: "memory");
#pragma unroll
        for (int t = 0; t < 2; ++t)
#pragma unroll
            for (int s2 = 0; s2 < 2; ++s2) {
                const int row = 32 * t + 16 * s2 + 4 * h + tq;
#pragma unroll
                for (int dh = 0; dh < 2; ++dh) {
                    const int ch = 4 * dh + 2 * tg + (tp >> 1), off = (((ch ^ (row & 7)) << 4) + ((tp & 1) << 3));
                    const bf16x8 bf = cat8(trd((const LAS bf16_t*)(Vt + row * 128 + off)), trd((const LAS bf16_t*)(Vt + (row + 8) * 128 + off)));
                    O[0][dh] = MFMA32(pf[0][2 * t + s2], bf, O[0][dh]); O[1][dh] = MFMA32(pf[1][2 * t + s2], bf, O[1][dh]);
                }
            }
        asm volatile("s_waitcnt lgkmcnt(0)" ::: "memory");
        if (j < 8) att_dma_tile(kbn + 512, Vt, lane);
        asm volatile("" ::: "memory");
    }
#pragma unroll
    for (int qt = 0; qt < 2; ++qt) {
        float l = lsum[qt]; l += __shfl_xor(l, 32);
        if (h == 0) scr[r] = l;
        asm volatile("s_waitcnt lgkmcnt(0)" ::: "memory");
#pragma unroll
        for (int i = 0; i < 16; ++i) { const int q = crow(i, h); const float inv = __builtin_amdgcn_rcpf(scr[q]);
            bf16_t* op = cols + (size_t)(tq0 + 32 * qt + q) * INC + 3584 + hh * 64 + r;
            const bf16_t o0 = f2bf(O[qt][0][i] * inv), o1 = f2bf(O[qt][1][i] * inv); if (!dry) { op[0] = o0; op[32] = o1; } }
        asm volatile("s_waitcnt lgkmcnt(0)" ::: "memory");
    }
    asm volatile("s_waitcnt vmcnt(0)" ::: "memory");
}
DI void attn_phase(const Params& P, LAS unsigned char* lds, int l, int dry = 0) {
    const int tid = otid(), lane = tid & 63, wid = __builtin_amdgcn_readfirstlane(tid >> 6);
    LAS float* bias = (LAS float*)(lds + ATT_BIAS_OFF); const float* rb = P.in[I_RB] + l * 8 * 257;
    __syncthreads();
    for (int i = tid; i < 8 * 257; i += 512) bias[(i / 257) * 264 + (i % 257)] = rb[i] * LOG2E;
    __syncthreads();
    bf16_t* cols = (bf16_t*)(P.ws + WS_COLS);
    for (int u = obid() * 8 + wid; u < 4096; u += gridDim.x * 8) {
        const int c = u & 127, hh = (u >> 7) & 7, bl = u >> 10;
        attn_unit(cols, lds, wid, lane, bl, hh, c, dry);
    }
    asm volatile("s_waitcnt vmcnt(0)" ::: "memory");
    __syncthreads();
}

DI void final_norm(const Params& P, int dry = 0) {
    const int tid = otid(), lane = tid & 63, wid = tid >> 6; const float* ssq = (const float*)(P.ws + WS_SSQ); const float* w = P.in[I_FN]; const bf16_t* xb = (const bf16_t*)(P.ws + WS_XB);
    for (int row0 = (obid() * 8 + wid) * 4; row0 < MTOK; row0 += gridDim.x * 32) {
        u32x4 xv[4][2]; float rs[4];
#pragma unroll
        for (int q = 0; q < 4; ++q) { rs[q] = row_rstd(ssq, row0 + q);
#pragma unroll
            for (int j = 0; j < 2; ++j) xv[q][j] = *(const u32x4*)(xb + (size_t)(row0 + q) * DM + 512 * j + 8 * lane); }
#pragma unroll
        for (int q = 0; q < 4; ++q)
#pragma unroll
            for (int j = 0; j < 2; ++j) {
                const int c0 = 512 * j + 8 * lane; const u32x4 t = xv[q][j];
                const f32x4 g0 = *(const f32x4*)(w + c0), g1 = *(const f32x4*)(w + c0 + 4);
                const f32x4 o0 = (f32x4){bflo(t.x), bfhi(t.x), bflo(t.y), bfhi(t.y)} * rs[q] * g0, o1 = (f32x4){bflo(t.z), bfhi(t.z), bflo(t.w), bfhi(t.w)} * rs[q] * g1;
                if (!dry) { *(f32x4*)(P.out + (size_t)(row0 + q) * DM + c0) = o0; *(f32x4*)(P.out + (size_t)(row0 + q) * DM + c0 + 4) = o1; }
            }
    }
}

#define XB_TMO      128
#define XB_XCNT(j)  (256  + 64 * (j))
#define XB_XSUB(j)  (1280 + 64 * (j))
#define XB_XGEN(j)  (2304 + 64 * (j))
#define XB_TOP      3328
#define XB_TOPGEN   3392
#define XB_SPIN_CAP (1u << 22)
DI unsigned xb_ld(unsigned* p)              { return __hip_atomic_load(p, __ATOMIC_RELAXED, __HIP_MEMORY_SCOPE_AGENT); }
DI unsigned xb_add(unsigned* p, unsigned v) { return __hip_atomic_fetch_add(p, v, __ATOMIC_RELAXED, __HIP_MEMORY_SCOPE_AGENT); }
DI unsigned xb_xcc_id() { return (unsigned)__builtin_amdgcn_s_getreg((3 << 11) | 20) & 0xFu; }
#define XB_SPIN(cond, bar) do { unsigned _sp = 0; while (cond) { __builtin_amdgcn_s_sleep(1); \
    if ((++_sp & 255u) == 0u) { if (xb_ld(&(bar)[XB_TMO])) break; if (_sp > XB_SPIN_CAP) { atomicAdd(&(bar)[XB_TMO], 1u); break; } } } } while (0)
struct XcdBarrier { unsigned* bar; unsigned x; volatile LAS unsigned* st; };
DI XcdBarrier xcd_barrier_post(unsigned* bar, volatile LAS unsigned* st) {
    XcdBarrier b; b.bar = bar; b.x = xb_xcc_id(); b.st = st;
    if (threadIdx.x == 0) (void)xb_add(&bar[XB_XCNT(b.x)], 1u);
    return b;
}
DI void xcd_barrier_complete(unsigned* bar, unsigned x, unsigned& nloc, unsigned& nx) {
    const unsigned G = gridDim.x * gridDim.y * gridDim.z;
    unsigned sum, cnt, mine, sp = 0u;
    for (;;) {
        sum = 0u; cnt = 0u; mine = 0u;
#pragma unroll
        for (unsigned j = 0; j < 16; ++j) { const unsigned c = xb_ld(&bar[XB_XCNT(j)]); sum += c; cnt += (c > 0u) ? 1u : 0u; mine = (j == x) ? c : mine; }
        if (sum == G) break;
        __builtin_amdgcn_s_sleep(1);
        if ((++sp & 255u) == 0u) { if (xb_ld(&bar[XB_TMO])) break; if (sp > XB_SPIN_CAP) { atomicAdd(&bar[XB_TMO], 1u); break; } }
    }
    nloc = mine > 0u ? mine : 1u; nx = cnt > 0u ? cnt : 1u;
}
DI void xcd_barrier(const XcdBarrier& b) {
    asm volatile("s_waitcnt vmcnt(0)" ::: "memory");
    __syncthreads();
    if (threadIdx.x == 0) {
        unsigned* bar = b.bar;
        __builtin_amdgcn_s_waitcnt(0);
        unsigned nloc = b.st[0], nx = b.st[1];
        if (nloc == 0u) { xcd_barrier_complete(bar, b.x, nloc, nx); b.st[0] = nloc; b.st[1] = nx; }
        const unsigned old = xb_add(&bar[XB_XSUB(b.x)], 1u);
        const unsigned gen = old / nloc;
        if (old + 1u == (gen + 1u) * nloc) {
            __builtin_amdgcn_fence(__ATOMIC_RELEASE, "agent");
            asm volatile("s_waitcnt vmcnt(0)" ::: "memory");
            const unsigned og = xb_add(&bar[XB_TOP], 1u);
            const unsigned tg = og / nx;
            if (og + 1u == (tg + 1u) * nx) xb_add(&bar[XB_TOPGEN], 1u);
            else XB_SPIN(xb_ld(&bar[XB_TOPGEN]) == tg, bar);
            __builtin_amdgcn_fence(__ATOMIC_ACQUIRE, "agent");
            xb_add(&bar[XB_XGEN(b.x)], 1u);
            asm volatile("s_waitcnt vmcnt(0)" ::: "memory");
        } else {
            XB_SPIN(xb_ld(&bar[XB_XGEN(b.x)]) == gen, bar);
            __builtin_amdgcn_fence(__ATOMIC_ACQUIRE, "agent");
            asm volatile("s_waitcnt vmcnt(0)" ::: "memory");
        }
    }
    __syncthreads();
}

constexpr int NPHASE = 30;
__global__ void __launch_bounds__(512, 2) fwd_kernel(Params Parg) {
    extern __shared__ __attribute__((aligned(16))) unsigned char lds_raw[];
    LAS unsigned char* lds = (LAS unsigned char*)lds_raw;
    const int G = gridDim.x;
    typedef const __attribute__((address_space(4))) Params* KP;
    const KP Pk = (KP)__builtin_amdgcn_kernarg_segment_ptr();
    const int ph_lo = Pk->lo, ph_hi = Pk->hi;
#define XB ((bf16_t*)(ws + WS_XB))
#define COLS ((bf16_t*)(ws + WS_COLS))
#define GB ((bf16_t*)(ws + WS_G))
#define HID ((bf16_t*)(ws + WS_HID))
#define SSQ ((float*)(ws + WS_SSQ))
    volatile LAS unsigned* MISC = (volatile LAS unsigned*)(lds + LDS_BYTES - 64);
    if (threadIdx.x < 4) MISC[threadIdx.x] = 0u;
    __syncthreads();
    XcdBarrier bar; bar.bar = (unsigned*)(Pk->ws + WS_BAR); bar.x = 0; bar.st = MISC;
    for (int ph = ph_lo; ph < ph_hi; ++ph) {
        if (ph > ph_lo) {
            if (ph == ph_lo + 1) { cg::this_grid().sync(); bar = xcd_barrier_post((unsigned*)(Pk->ws + WS_BAR), MISC); }
            else xcd_barrier(bar);
        }
        KP Pp = Pk; asm volatile("" : "+s"(Pp));
        const Params& P = *(const Params*)Pp;
        unsigned char* ws = P.ws;
        if (ph == 0) { prologue(P, lds); if (PROBE == 3) prologue(P, lds); continue; }
        if (ph == NPHASE - 1) { if (PROBE == 3) final_norm(P, P.hi != 12345); final_norm(P); continue; }
        const int l = (ph - 1) / 14, k = (ph - 1) % 14;
        unsigned char* wl = ws + WS_WT + (size_t)l * WLAYER;
        pg8::StaticOrder S;
        if (k == 0 || k == 12) {
            pg8::Gemm g{XB, (const bf16_t*)(wl + (k == 0 ? WO1 : WO6)), DM, DM, 128, 256 * DM * 2}; S.init(MTOK, 2 * DFF, G, obid());
            pg8::EpiGateUp E{HID, SSQ, 0};
#if PROBE == 11
            { pg8::EpiGateUp Ed = E; Ed.dry = (P.hi != 12345); pg8::gemm_phase<pg8::EpiGateUp>(lds, g, S, Ed); }
#endif
            for (int rep = 0; rep < (PROBE == 2 ? 2 : 1); ++rep) pg8::gemm_phase<pg8::EpiGateUp>(lds, g, S, E, STAGGER);
        } else if (k == 1 || k == 13) {
            pg8::Gemm g{HID, (const bf16_t*)(wl + (k == 1 ? WO2 : WO7)), DFF, 64, 32768, (DFF / 64) * 32768}; S.init(MTOK, DM, G, obid());
            pg8::EpiResid E{(l == 0 && k == 1) ? P.in[I_X] : (const float*)nullptr, (float*)nullptr, XB, SSQ, 0.5f, 0, 0, XB, SSQ};
#if PROBE == 9
            { pg8::EpiResid Ed = E; Ed.xout32 = nullptr; Ed.xbo = (bf16_t*)(ws + (P.hi != 12345 ? 848 * MiB : WS_XB)); Ed.ssqo = (float*)(ws + (P.hi != 12345 ? 980 * MiB : WS_SSQ)); pg8::gemm_phase<pg8::EpiResid>(lds, g, S, Ed); }
#endif
#if PROBE == 4 || PROBE == 10
            { pg8::EpiResid Ed = E; Ed.dry = (P.hi != 12345); pg8::gemm_phase<pg8::EpiResid>(lds, g, S, Ed); }
#endif
            pg8::gemm_phase<pg8::EpiResid>(lds, g, S, E);
        } else {
            const int half = (k - 2) / 5, kk = (k - 2) % 5, row0 = half * HROWS;
            if (kk == 0) {
                pg8::Gemm g{XB + (size_t)row0 * DM, (const bf16_t*)(wl + WO3), DM, DM, 128, 256 * DM * 2}; S.init(HROWS, NCAT, G, obid());
                pg8::EpiInProj E{COLS, (unsigned char*)GB, SSQ, (const float*)(ws + WS_COS), (const float*)(ws + WS_SIN), row0, 0};
#if PROBE == 11
                { pg8::EpiInProj Ed = E; Ed.dry = (P.hi != 12345); pg8::gemm_phase<pg8::EpiInProj>(lds, g, S, Ed); }
#endif
                for (int rep = 0; rep < (PROBE == 2 ? 2 : 1); ++rep) pg8::gemm_phase<pg8::EpiInProj>(lds, g, S, E, STAGGER);
            } else if (kk == 1) {
#if PROBE == 1
                if (P.hi != 12345) { for (int u = obid(); u < 256; u += G) ret_local_unit(P, lds, u); conv_phase(P, l, P.hi != 12345); }
#endif
                if (HAS(4)) { for (int u = obid(); u < 256; u += G) ret_local_unit(P, lds, u);
                conv_phase(P, l); }
            } else if (kk == 2) {
#if PROBE == 1
                if (P.hi != 12345) { for (int u = obid(); u < 256; u += G) ret_scan_unit(P, lds, u, P.hi != 12345); attn_phase(P, lds, l, P.hi != 12345); }
#endif
                if (HAS(5)) for (int u = obid(); u < 256; u += G) ret_scan_unit(P, lds, u);
                if (HAS(6)) attn_phase(P, lds, l);
            } else if (kk == 3) {
                pg8::Gemm g{COLS, (const bf16_t*)(wl + WO4), 512, INC, 128, 256 * INC * 2}; S.init(HROWS, DM, G, obid(), 1);
                pg8::EpiBranch E{(const unsigned char*)GB, (bf16_t*)(ws + WS_MB), 0};
#if PROBE == 12
                { pg8::EpiBranch Ed = E; Ed.dry = (P.hi != 12345); pg8::gemm_phase<pg8::EpiBranch, true>(lds, g, S, Ed); }
#endif
                pg8::gemm_phase<pg8::EpiBranch, true>(lds, g, S, E);
            } else {
                pg8::Gemm g{(const bf16_t*)(ws + WS_MB), (const bf16_t*)(wl + WO5), DM, DM, 128, 256 * DM * 2}; S.init(HROWS, DM, G, obid());
                pg8::EpiResid E{nullptr, nullptr, XB, SSQ, 1.0f, row0, 0, XB, SSQ};
#if PROBE == 9
                { pg8::EpiResid Ed = E; Ed.xbo = (bf16_t*)(ws + (P.hi != 12345 ? 848 * MiB : WS_XB)); Ed.ssqo = (float*)(ws + (P.hi != 12345 ? 980 * MiB : WS_SSQ)); pg8::gemm_phase<pg8::EpiResid>(lds, g, S, Ed); }
#endif
#if PROBE == 4 || PROBE == 10
                { pg8::EpiResid Ed = E; Ed.dry = (P.hi != 12345); pg8::gemm_phase<pg8::EpiResid>(lds, g, S, Ed); }
#endif
                pg8::gemm_phase<pg8::EpiResid>(lds, g, S, E);
            }
        }
    }
}

extern "C" void kernel_launch(void* const* d_in, const int* in_sizes, int n_in, void* d_out, int out_size, void* d_ws, size_t ws_size, hipStream_t stream) {
    static int grid = 0;
    if (grid == 0) {
        if (n_in != 17 || out_size != MTOK * DM || ws_size < WS_END) { fprintf(stderr, "kernel_launch: unexpected shapes (n_in %d out %d ws %zu)\n", n_in, out_size, ws_size); grid = -1; return; }
        int dev = 0, cus = 0, per_cu = 0;
        (void)hipGetDevice(&dev); (void)hipDeviceGetAttribute(&cus, hipDeviceAttributeMultiprocessorCount, dev);
        (void)hipFuncSetAttribute((const void*)fwd_kernel, hipFuncAttributeMaxDynamicSharedMemorySize, LDS_BYTES);
        if (hipOccupancyMaxActiveBlocksPerMultiprocessor(&per_cu, (const void*)fwd_kernel, 512, LDS_BYTES) != hipSuccess || per_cu < 1) per_cu = 1;
        (void)hipGetLastError();
        if (cus <= 0) cus = 256;
        grid = cus * per_cu;
    }
    if (grid < 0) return;
    Params p{};
    for (int i = 0; i < 17; ++i) p.in[i] = (const float*)d_in[i];
    p.out = (float*)d_out; p.ws = (unsigned char*)d_ws;
    for (int i = 0; i < 64; ++i) p.invf[i] = powf(10000.0f, -((float)i / 63.0f));
#if MK_MULTI
    for (int ph = 0; ph < NPHASE; ++ph) { p.lo = ph; p.hi = ph + 1; hipLaunchKernelGGL(fwd_kernel, dim3(grid), dim3(512), LDS_BYTES, stream, p); }
#else
    p.lo = 0; p.hi = NPHASE;
    void* args[] = {&p};
    hipError_t e = hipLaunchCooperativeKernel((const void*)fwd_kernel, dim3(grid), dim3(512), args, LDS_BYTES, stream);
    if (e != hipSuccess) fprintf(stderr, "cooperative launch failed: %s (grid %d)\n", hipGetErrorString(e), grid);
#endif
}
```

```cpp
#include <hip/hip_runtime.h>
#include <hip/hip_cooperative_groups.h>
#include <cstdio>
#include <cstdint>
#include <cmath>
namespace cg = cooperative_groups;

#ifndef MK_MULTI
#define MK_MULTI 0
#endif

#ifndef PROBE
#define PROBE 0
#endif
#ifndef STAGGER
#define STAGGER 0
#endif
#ifndef PH_MASK
#define PH_MASK 0x1ff
#endif
#define HAS(x) (((PH_MASK) >> (x)) & 1)
#define DI __device__ __forceinline__
#define LAS __attribute__((address_space(3)))
typedef unsigned short bf16_t;
typedef short bf16x8 __attribute__((ext_vector_type(8)));
typedef float f32x4 __attribute__((ext_vector_type(4)));
typedef float f32x16 __attribute__((ext_vector_type(16)));
typedef unsigned u32x4 __attribute__((ext_vector_type(4)));
typedef unsigned u32x2 __attribute__((ext_vector_type(2)));
typedef float f32x2_t __attribute__((ext_vector_type(2)));
typedef __bf16 bf16x2_t __attribute__((ext_vector_type(2)));

constexpr int DM = 1024, SEQ = 8192, NBATCH = 8, MTOK = NBATCH * SEQ, DFF = 2816, INC = 5120, GZ = 3072, NCAT = INC + GZ;
constexpr int HROWS = MTOK / 2;
constexpr float EPS = 1e-6f;
constexpr float LOG2E = 1.4426950408889634f;
constexpr size_t MiB = (size_t)1 << 20;
constexpr size_t WS_BAR = 0;
constexpr size_t WS_SSQ = 1 * MiB;
constexpr size_t WS_COS = 5 * MiB, WS_SIN = 7 * MiB;
constexpr size_t WS_T = 9 * MiB;
constexpr size_t WS_WT = 26 * MiB;
constexpr size_t WO1 = 0, WO2 = WO1 + (size_t)2 * DFF * DM * 2, WO3 = WO2 + (size_t)DM * DFF * 2, WO4 = WO3 + (size_t)NCAT * DM * 2,
                 WO5 = WO4 + (size_t)GZ * 512 * 2, WO6 = WO5 + (size_t)DM * DM * 2, WO7 = WO6 + (size_t)2 * DFF * DM * 2, WLAYER = WO7 + (size_t)DM * DFF * 2;
constexpr size_t WS_XB = 144 * MiB;
constexpr size_t WS_COLS = 272 * MiB;
constexpr size_t WS_G = 592 * MiB;
constexpr size_t WS_HID = 272 * MiB;
constexpr size_t WS_MB = 784 * MiB;
constexpr size_t WS_END = 848 * MiB;
static_assert(WS_WT + 2 * WLAYER <= WS_XB && WS_HID + (size_t)MTOK * DFF * 2 <= WS_END && WS_COLS + (size_t)HROWS * INC * 2 <= WS_G, "ws map");
#define XCD_BAR_WORDS 3456
constexpr int LDS_BYTES = 147456;

DI int otid() { int t = threadIdx.x; asm volatile("" : "+v"(t)); return t; }
DI int obid() { int b = blockIdx.x; asm volatile("" : "+s"(b)); return b; }
DI unsigned pk2(float lo, float hi) { f32x2_t v = {lo, hi}; bf16x2_t b = __builtin_convertvector(v, bf16x2_t); return __builtin_bit_cast(unsigned, b); }
DI float bflo(unsigned w) { return __uint_as_float(w << 16); }
DI float bfhi(unsigned w) { return __uint_as_float(w & 0xffff0000u); }
DI float bf2f(bf16_t u) { return __uint_as_float(((unsigned)u) << 16); }
DI bf16_t f2bf(float f) { return (bf16_t)(pk2(f, 0.f) & 0xffffu); }
DI float ex2(float x) { return __builtin_amdgcn_exp2f(x); }
DI float sigm(float v) { return __builtin_amdgcn_rcpf(1.f + ex2(-LOG2E * v)); }
DI unsigned q8(float g) { return (unsigned)(g * 255.f + 0.5f); }
DI unsigned pkq4(float a, float b, float c, float d) { return q8(a) | (q8(b) << 8) | (q8(c) << 16) | (q8(d) << 24); }
DI float ub(unsigned w, int k) { return (float)((w >> (8 * k)) & 0xffu); }
DI int crow(int reg, int h) { return (reg & 3) + 8 * (reg >> 2) + 4 * h; }
#define MFMA32(a, b, c) __builtin_amdgcn_mfma_f32_32x32x16_bf16((a), (b), (c), 0, 0, 0)
DI bf16x8 pack8(float a0, float a1, float a2, float a3, float a4, float a5, float a6, float a7) {
    u32x4 p; p.x = pk2(a0, a1); p.y = pk2(a2, a3); p.z = pk2(a4, a5); p.w = pk2(a6, a7); return __builtin_bit_cast(bf16x8, p);
}
typedef short v4i16_t __attribute__((ext_vector_type(4)));
DI v4i16_t trd(const LAS bf16_t* p) { return __builtin_amdgcn_ds_read_tr16_b64_v4i16((LAS v4i16_t*)p); }
DI bf16x8 cat8(v4i16_t lo, v4i16_t hi) { return __builtin_shufflevector(lo, hi, 0, 1, 2, 3, 4, 5, 6, 7); }
#ifndef NT_STORE
#define NT_STORE 0
#endif
DI void st16(void* p, u32x4 v) {
#if NT_STORE == 1
    __builtin_nontemporal_store(v, (u32x4*)p);
#elif NT_STORE == 2
    asm volatile("global_store_dwordx4 %0, %1, off sc1" :: "v"(p), "v"(v) : "memory");
#else
    *(u32x4*)p = v;
#endif
}
DI float row_rstd(const float* ssq, int grow) {
    const f32x4* p = (const f32x4*)(ssq + (size_t)grow * 16); const f32x4 a = p[0], b = p[1], c = p[2], d = p[3];
    const float s = ((a.x + a.y) + (a.z + a.w)) + ((b.x + b.y) + (b.z + b.w)) + ((c.x + c.y) + (c.z + c.w)) + ((d.x + d.y) + (d.z + d.w));
    return __builtin_amdgcn_rsqf(s * (1.f / DM) + EPS);
}

namespace pg8 {
constexpr int BM = 256, BK = 64, HALF = 128, HTB = HALF * BK * 2, STAGE_BYTES = 8 * HTB, NXCD = 8, WGM = 8;
__host__ __device__ __forceinline__ int lds_byte(int r, int c) { const int st = (r >> 4) * 2 + (c >> 5), rr = r & 15, cc = c & 31, ob = rr * 64 + cc * 2; return st * 1024 + (ob ^ (((ob >> 9) & 1) << 5)); }
__host__ __device__ __forceinline__ void stage_rc(int b, int& R, int& C) { const int st = b / 1024, sb = b % 1024, swz = sb ^ (((sb >> 9) & 1) << 5); R = (st >> 1) * 16 + swz / 64; C = (st & 1) * 32 + (swz % 64) / 2; }
__host__ __device__ __forceinline__ int perm32(int rho) { const int n = rho >> 4, i = rho & 15; return 8 * (i >> 2) + 4 * n + (i & 3); }
struct Unit { int pm, pn; };
struct Gemm { const bf16_t* A; const bf16_t* Bt; int K, lda; int kstepA, tA; };
struct StaticOrder {
    int nM, nN, nwg, G, c;
    __device__ void init(int M, int N, int G_, int c_, int br3_ = 0) { nM = M / BM; nN = N / BM; nwg = nM * nN; G = G_; c = c_; br3 = br3_; }
    int br3;
    __device__ bool next(int i, Unit& u) const {
        if (br3) { const int b = i % 3; if (!next1(i / 3, u)) return false; u.pn += b * nN; return true; }
        return next1(i, u);
    }
    __device__ bool next1(int i, Unit& u) const {
        const long L = (long)i * G + c; if (L >= nwg) return false;
        int wgid = (int)L; { const int q = nwg / NXCD, r = nwg % NXCD, xcd = wgid % NXCD, off = wgid / NXCD; wgid = (xcd < r ? xcd * (q + 1) : r * (q + 1) + (xcd - r) * q) + off; }
        const int nig = WGM * nN, gid = wgid / nig, fm = gid * WGM, gsz = (nM - fm) < WGM ? (nM - fm) : WGM;
        u.pm = fm + ((wgid % nig) % gsz); u.pn = (wgid % nig) / gsz; return true;
    }
};
template <class Epi, bool BR = false>
DI void gemm_phase(LAS unsigned char* lds, const Gemm g, const StaticOrder& S, const Epi& E, int stagger = 0) {
    const int tid = otid(), wid = __builtin_amdgcn_readfirstlane(tid >> 6), lane = tid & 63, wr = wid >> 2, wc = wid & 3, fr = lane & 15, fq = lane >> 4;
    const int K = g.K, nt = K / BK, lda = g.lda;
    unsigned voffA[2], voffB[2];
#pragma unroll
    for (int i = 0; i < 2; ++i) { int R, C; stage_rc(tid * 16 + i * 8192, R, C); const int Rb = 64 * (R >> 5) + perm32(R & 31);
        voffA[i] = (unsigned)(R * lda + C) * 2u; voffB[i] = (unsigned)(Rb * K + C) * 2u; }
    const size_t kstep = (size_t)(BK * 2);
    const size_t hA = (size_t)HALF * lda * 2, tA = (size_t)g.tA, kstepA = (size_t)g.kstepA;
    const size_t hB = (size_t)32 * K * 2, tB = (size_t)BM * K * 2;
    const unsigned ldsw = (unsigned)wid * 1024u;
    const int aoff = lds_byte(wr * 64 + fr, fq * 8), boff = lds_byte(wc * 32 + fr, fq * 8);
#define PG8_SA(b, h) (((b) * 2 + (h)) * HTB)
#define PG8_SB(b, h) ((4 + (b) * 2 + (h)) * HTB)
#define PG8_STAGE(bufoff, gbase, voff) do { _Pragma("unroll") for (int _i = 0; _i < 2; ++_i) \
        __builtin_amdgcn_global_load_lds((const unsigned*)((const char*)(gbase) + (voff)[_i]), (LAS unsigned*)(lds + (bufoff) + ldsw + _i * 8192), 16, 0, 0); } while (0)
#define PG8_LDA(dst, b, h) do { _Pragma("unroll") for (int m = 0; m < 4; ++m) _Pragma("unroll") for (int k = 0; k < 2; ++k) dst[m][k] = *(const LAS bf16x8*)(lds + PG8_SA(b, h) + aoff + m * 2048 + k * 1024); } while (0)
#define PG8_LDB(dst, b, h) do { _Pragma("unroll") for (int n = 0; n < 2; ++n) _Pragma("unroll") for (int k = 0; k < 2; ++k) dst[n][k] = *(const LAS bf16x8*)(lds + PG8_SB(b, h) + boff + n * 2048 + k * 1024); } while (0)
#define PG8_MMA(ai, bj, At, Bt) do { __builtin_amdgcn_s_setprio(1); _Pragma("unroll") for (int m = 0; m < 4; ++m) _Pragma("unroll") for (int n = 0; n < 2; ++n) _Pragma("unroll") for (int k = 0; k < 2; ++k) \
        acc[ai][bj][m][n] = __builtin_amdgcn_mfma_f32_16x16x32_bf16(Bt[n][k], At[m][k], acc[ai][bj][m][n], 0, 0, 0); __builtin_amdgcn_s_setprio(0); } while (0)
#define PG8_WAIT_V(n) asm volatile("s_waitcnt vmcnt(" #n ")" ::: "memory")
#define PG8_WAIT_L(n) asm volatile("s_waitcnt lgkmcnt(" #n ")" ::: "memory")
#define PG8_BAR __builtin_amdgcn_s_barrier()
#define PG8_SCHED __builtin_amdgcn_sched_barrier(0)
#define PG8_ACOL(u) (BR ? (((u).pn >> 2) == 0 ? 512 : (((u).pn >> 2) == 1 ? 3072 : 3584)) : 0)
    Unit cur, nxt; int ui = 0;
    if (!S.next(0, cur)) return;
    if (stagger > 0) { const unsigned cls = ((unsigned)S.c >> 3) & 3u; const unsigned long long t0 = __builtin_amdgcn_s_memrealtime();
        while (__builtin_amdgcn_s_memrealtime() - t0 < (unsigned long long)(cls * (unsigned)stagger)) __builtin_amdgcn_s_sleep(8); }
    f32x4 acc[2][2][4][2];
#pragma unroll
    for (int a = 0; a < 2; ++a)
#pragma unroll
        for (int b = 0; b < 2; ++b)
#pragma unroll
            for (int m = 0; m < 4; ++m)
#pragma unroll
                for (int n = 0; n < 2; ++n) acc[a][b][m][n] = (f32x4){0.f, 0.f, 0.f, 0.f};
    bf16x8 At[4][2], B0[2][2], B1[2][2];
    const char* cA = (const char*)g.A + (size_t)cur.pm * tA + (size_t)PG8_ACOL(cur) * 2; const char* cB = (const char*)g.Bt + (size_t)cur.pn * tB;
    PG8_STAGE(PG8_SB(0, 0), cB, voffB); PG8_STAGE(PG8_SB(0, 1), cB + hB, voffB); PG8_STAGE(PG8_SA(0, 0), cA, voffA); PG8_STAGE(PG8_SA(0, 1), cA + hA, voffA);
    if (wr == 1) PG8_BAR;
    PG8_WAIT_V(2); PG8_BAR;
    PG8_STAGE(PG8_SB(1, 0), cB + kstep, voffB); PG8_STAGE(PG8_SA(1, 0), cA + kstepA, voffA); PG8_STAGE(PG8_SB(1, 1), cB + hB + kstep, voffB);
    PG8_WAIT_V(6); PG8_BAR;
    for (;;) {
        const bool has_next = S.next(ui + 1, nxt);
        const char* nA = has_next ? (const char*)g.A + (size_t)nxt.pm * tA + (size_t)PG8_ACOL(nxt) * 2 : cA; const char* nB = has_next ? (const char*)g.Bt + (size_t)nxt.pn * tB : cB;
        for (int t = 0; t < nt; t += 2) {
            const bool last = (t == nt - 2);
            const char* a1 = cA + (size_t)(t + 1) * kstepA;
            const char* a2 = last ? nA : cA + (size_t)(t + 2) * kstepA; const char* b2 = last ? nB : cB + (size_t)(t + 2) * kstep;
            const char* a3 = a2 + kstepA; const char* b3 = b2 + kstep;
            PG8_LDB(B0, 0, 0); PG8_LDB(B1, 0, 1); PG8_SCHED; PG8_LDA(At, 0, 0); PG8_STAGE(PG8_SA(1, 1), a1 + hA, voffA);
            PG8_WAIT_V(8); PG8_WAIT_L(0); PG8_BAR; PG8_MMA(0, 0, At, B0); PG8_MMA(0, 1, At, B1); PG8_BAR; PG8_SCHED;
            PG8_LDA(At, 0, 1); PG8_STAGE(PG8_SB(0, 0), b2, voffB); PG8_STAGE(PG8_SB(0, 1), b2 + hB, voffB); PG8_STAGE(PG8_SA(0, 0), a2, voffA);
            PG8_WAIT_V(8); PG8_WAIT_L(0); PG8_BAR; PG8_MMA(1, 0, At, B0); PG8_MMA(1, 1, At, B1); PG8_BAR; PG8_SCHED;
            PG8_LDB(B0, 1, 0); PG8_LDB(B1, 1, 1); PG8_SCHED; PG8_LDA(At, 1, 0); PG8_STAGE(PG8_SA(0, 1), a2 + hA, voffA);
            PG8_WAIT_V(8); PG8_WAIT_L(0); PG8_BAR; PG8_MMA(0, 0, At, B0); PG8_MMA(0, 1, At, B1); PG8_BAR; PG8_SCHED;
            PG8_LDA(At, 1, 1); PG8_STAGE(PG8_SB(1, 0), b3, voffB); PG8_STAGE(PG8_SB(1, 1), b3 + hB, voffB); PG8_STAGE(PG8_SA(1, 0), a3, voffA);
            PG8_WAIT_V(8); PG8_WAIT_L(0); PG8_BAR; PG8_MMA(1, 0, At, B0); PG8_MMA(1, 1, At, B1); PG8_BAR; PG8_SCHED;
        }
        if (wr == 0) PG8_BAR;
        E(acc, cur, wr, wc, fr, fq);
        if (!has_next) break;
#pragma unroll
        for (int a = 0; a < 2; ++a)
#pragma unroll
            for (int b = 0; b < 2; ++b)
#pragma unroll
                for (int m = 0; m < 4; ++m)
#pragma unroll
                    for (int n = 0; n < 2; ++n) acc[a][b][m][n] = (f32x4){0.f, 0.f, 0.f, 0.f};
        cur = nxt; cA = nA; cB = nB; ++ui;
        if (wr == 1) PG8_BAR;
    }
    PG8_WAIT_V(0);
    PG8_BAR;
#undef PG8_SA
#undef PG8_SB
#undef PG8_STAGE
#undef PG8_LDA
#undef PG8_LDB
#undef PG8_MMA
#undef PG8_WAIT_V
#undef PG8_WAIT_L
#undef PG8_BAR
#undef PG8_SCHED
#undef PG8_ACOL
}

struct EpiGateUp {
    bf16_t* H; const float* ssq; int dry;
    DI void operator()(const f32x4 (&acc)[2][2][4][2], const Unit& u, int wr, int wc, int fr, int fq) const {
        const int lane = fr + 16 * fq;
        const float rs0 = row_rstd(ssq, u.pm * BM + wr * 64 + lane), rs1 = row_rstd(ssq, u.pm * BM + HALF + wr * 64 + lane);
        asm volatile("" ::: "memory");
#pragma unroll
        for (int ai = 0; ai < 2; ++ai)
#pragma unroll
            for (int m = 0; m < 4; ++m) {
                const int r = u.pm * BM + ai * HALF + wr * 64 + m * 16 + fr; const float rs = __shfl(ai ? rs1 : rs0, m * 16 + fr);
                float hv[8];
#pragma unroll
                for (int n = 0; n < 2; ++n)
#pragma unroll
                    for (int j = 0; j < 4; ++j) { const float gt = acc[ai][0][m][n][j] * rs, up = acc[ai][1][m][n][j] * rs; hv[4 * n + j] = gt * sigm(gt) * up; }
                u32x4 w; w.x = pk2(hv[0], hv[1]); w.y = pk2(hv[2], hv[3]); w.z = pk2(hv[4], hv[5]); w.w = pk2(hv[6], hv[7]);
                if (!dry) st16(H + ((size_t)(u.pm * (DFF / 64) + 2 * u.pn + (wc >> 1)) * 256 + (ai * HALF + wr * 64 + m * 16 + fr)) * 64 + 32 * (wc & 1) + 8 * fq, w);
            }
    }
};
struct EpiResid {
    const float* xin32; float* xout32; bf16_t* xb; float* ssq; float alpha; int row0; int dry; bf16_t* xbo; float* ssqo;
    DI void tail(const f32x4& v0, const f32x4& v1, size_t off, float& sq) const {
        if (!dry) {
            if (xout32) { *(f32x4*)(xout32 + off) = v0; *(f32x4*)(xout32 + off + 4) = v1; }
            else { u32x4 w; w.x = pk2(v0[0], v0[1]); w.y = pk2(v0[2], v0[3]); w.z = pk2(v1[0], v1[1]); w.w = pk2(v1[2], v1[3]); st16(xbo + off, w); }
        }
        sq += (v0[0] * v0[0] + v0[1] * v0[1]) + (v0[2] * v0[2] + v0[3] * v0[3]) + (v1[0] * v1[0] + v1[1] * v1[1]) + (v1[2] * v1[2] + v1[3] * v1[3]);
    }
    DI void operator()(const f32x4 (&acc)[2][2][4][2], const Unit& u, int wr, int wc, int fr, int fq) const {
        if (xin32) {
#pragma unroll
            for (int ai = 0; ai < 2; ++ai) {
                f32x4 v[4][2][2];
#pragma unroll
                for (int m = 0; m < 4; ++m)
#pragma unroll
                    for (int bj = 0; bj < 2; ++bj) { const size_t off = (size_t)(row0 + u.pm * BM + ai * HALF + wr * 64 + m * 16 + fr) * DM + u.pn * BM + wc * 64 + bj * 32 + 8 * fq;
                        v[m][bj][0] = *(const f32x4*)(xin32 + off); v[m][bj][1] = *(const f32x4*)(xin32 + off + 4); }
                asm volatile("" ::: "memory");
#pragma unroll
                for (int m = 0; m < 4; ++m) { const int r = row0 + u.pm * BM + ai * HALF + wr * 64 + m * 16 + fr; float sq = 0.f;
#pragma unroll
                    for (int bj = 0; bj < 2; ++bj) tail(v[m][bj][0] + acc[ai][bj][m][0] * alpha, v[m][bj][1] + acc[ai][bj][m][1] * alpha, (size_t)r * DM + u.pn * BM + wc * 64 + bj * 32 + 8 * fq, sq);
                    sq += __shfl_xor(sq, 16); sq += __shfl_xor(sq, 32);
                    if (fq == 0 && !dry) ssqo[(size_t)r * 16 + u.pn * 4 + wc] = sq; }
                asm volatile("" ::: "memory");
            }
        } else {
            u32x4 x0[4][2], x1[4][2];
#pragma unroll
            for (int m = 0; m < 4; ++m)
#pragma unroll
                for (int bj = 0; bj < 2; ++bj) x0[m][bj] = *(const u32x4*)(xb + (size_t)(row0 + u.pm * BM + wr * 64 + m * 16 + fr) * DM + u.pn * BM + wc * 64 + bj * 32 + 8 * fq);
            asm volatile("" ::: "memory");
#pragma unroll
            for (int m = 0; m < 4; ++m) { const int r = row0 + u.pm * BM + wr * 64 + m * 16 + fr; float sq = 0.f;
#pragma unroll
                for (int bj = 0; bj < 2; ++bj) x1[m][bj] = *(const u32x4*)(xb + (size_t)(r + HALF) * DM + u.pn * BM + wc * 64 + bj * 32 + 8 * fq);
                asm volatile("" ::: "memory");
#pragma unroll
                for (int bj = 0; bj < 2; ++bj) { const u32x4 t = x0[m][bj];
                    tail((f32x4){bflo(t.x), bfhi(t.x), bflo(t.y), bfhi(t.y)} + acc[0][bj][m][0] * alpha, (f32x4){bflo(t.z), bfhi(t.z), bflo(t.w), bfhi(t.w)} + acc[0][bj][m][1] * alpha,
                         (size_t)r * DM + u.pn * BM + wc * 64 + bj * 32 + 8 * fq, sq); }
                sq += __shfl_xor(sq, 16); sq += __shfl_xor(sq, 32);
                if (fq == 0 && !dry) ssqo[(size_t)r * 16 + u.pn * 4 + wc] = sq;
                asm volatile("" ::: "memory"); }
#pragma unroll
            for (int m = 0; m < 4; ++m) { const int r = row0 + u.pm * BM + HALF + wr * 64 + m * 16 + fr; float sq = 0.f;
#pragma unroll
                for (int bj = 0; bj < 2; ++bj) { const u32x4 t = x1[m][bj];
                    tail((f32x4){bflo(t.x), bfhi(t.x), bflo(t.y), bfhi(t.y)} + acc[1][bj][m][0] * alpha, (f32x4){bflo(t.z), bfhi(t.z), bflo(t.w), bfhi(t.w)} + acc[1][bj][m][1] * alpha,
                         (size_t)r * DM + u.pn * BM + wc * 64 + bj * 32 + 8 * fq, sq); }
                sq += __shfl_xor(sq, 16); sq += __shfl_xor(sq, 32);
                if (fq == 0 && !dry) ssqo[(size_t)r * 16 + u.pn * 4 + wc] = sq; }
        }
    }
};
struct EpiInProj {
    bf16_t* cols; unsigned char* G; const float* ssq; const float* cosT; const float* sinT; int row0; int dry;
    DI void operator()(const f32x4 (&acc)[2][2][4][2], const Unit& u, int wr, int wc, int fr, int fq) const {
        const int pn = u.pn, lane = fr + 16 * fq;
        const float rs0 = row_rstd(ssq, row0 + u.pm * BM + wr * 64 + lane), rs1 = row_rstd(ssq, row0 + u.pm * BM + HALF + wr * 64 + lane);
        asm volatile("" ::: "memory");
        if (pn < 2 || pn == 4 || pn == 5) {
            const int zt = pn < 2 ? pn : pn - 2;
#pragma unroll
            for (int ai = 0; ai < 2; ++ai)
#pragma unroll
                for (int m = 0; m < 4; ++m) {
                    const int rl = u.pm * BM + ai * HALF + wr * 64 + m * 16 + fr; const float rs = __shfl(ai ? rs1 : rs0, m * 16 + fr), rs2 = rs * rs;
                    const f32x4 z0 = acc[ai][0][m][0] * acc[ai][1][m][0] * rs2, z1 = acc[ai][0][m][1] * acc[ai][1][m][1] * rs2;
                    u32x4 w; w.x = pk2(z0[0], z0[1]); w.y = pk2(z0[2], z0[3]); w.z = pk2(z1[0], z1[1]); w.w = pk2(z1[2], z1[3]);
                    if (!dry) st16(cols + (size_t)rl * INC + zt * 128 + wc * 32 + 8 * fq, w);
                }
            return;
        }
#pragma unroll
        for (int ai = 0; ai < 2; ++ai)
#pragma unroll
            for (int m = 0; m < 4; ++m) {
                const int rl = u.pm * BM + ai * HALF + wr * 64 + m * 16 + fr; const float rs = __shfl(ai ? rs1 : rs0, m * 16 + fr);
                if (pn >= 20) {
#pragma unroll
                    for (int bj = 0; bj < 2; ++bj) { const f32x4 a0 = acc[ai][bj][m][0] * rs, a1 = acc[ai][bj][m][1] * rs;
                        u32x2 w; w.x = pkq4(sigm(a0[0]), sigm(a0[1]), sigm(a0[2]), sigm(a0[3])); w.y = pkq4(sigm(a1[0]), sigm(a1[1]), sigm(a1[2]), sigm(a1[3]));
                        if (!dry) *(u32x2*)(G + (size_t)rl * GZ + (pn - 20) * BM + wc * 64 + bj * 32 + 8 * fq) = w; }
                } else if (pn >= 6 && pn < 10) {
                    const int pos = (row0 + rl) & (SEQ - 1), hh = wc >> 1, dd0 = 32 * (wc & 1) + 8 * fq;
                    const f32x4 c0 = *(const f32x4*)(cosT + pos * 64 + dd0), c1 = *(const f32x4*)(cosT + pos * 64 + dd0 + 4);
                    const f32x4 s0 = *(const f32x4*)(sinT + pos * 64 + dd0), s1 = *(const f32x4*)(sinT + pos * 64 + dd0 + 4);
                    const f32x4 x10 = acc[ai][0][m][0] * rs, x11 = acc[ai][0][m][1] * rs, x20 = acc[ai][1][m][0] * rs, x21 = acc[ai][1][m][1] * rs;
                    const f32x4 y10 = x10 * c0 - x20 * s0, y11 = x11 * c1 - x21 * s1, y20 = x10 * s0 + x20 * c0, y21 = x11 * s1 + x21 * c1;
                    u32x4 w1, w2; w1.x = pk2(y10[0], y10[1]); w1.y = pk2(y10[2], y10[3]); w1.z = pk2(y11[0], y11[1]); w1.w = pk2(y11[2], y11[3]);
                    w2.x = pk2(y20[0], y20[1]); w2.y = pk2(y20[2], y20[3]); w2.z = pk2(y21[0], y21[1]); w2.w = pk2(y21[2], y21[3]);
                    bf16_t* p = cols + (size_t)rl * INC + pn * BM + hh * 128 + dd0;
                    if (!dry) { st16(p, w1); st16(p + 64, w2); }
                } else {
#pragma unroll
                    for (int bj = 0; bj < 2; ++bj) { const f32x4 a0 = acc[ai][bj][m][0] * rs, a1 = acc[ai][bj][m][1] * rs;
                        u32x4 w; w.x = pk2(a0[0], a0[1]); w.y = pk2(a0[2], a0[3]); w.z = pk2(a1[0], a1[1]); w.w = pk2(a1[2], a1[3]);
                        if (!dry) st16(cols + (size_t)rl * INC + pn * BM + wc * 64 + bj * 32 + 8 * fq, w); }
                }
            }
    }
};
struct EpiBranch {
    const unsigned char* Gt; bf16_t* Mb; int dry;
    DI void operator()(const f32x4 (&acc)[2][2][4][2], const Unit& u, int wr, int wc, int fr, int fq) const {
        const int br = u.pn >> 2, pc = u.pn & 3;
#pragma unroll
        for (int ai = 0; ai < 2; ++ai) {
            u32x2 gv[4][2]; u32x4 mv[4][2];
#pragma unroll
            for (int m = 0; m < 4; ++m)
#pragma unroll
                for (int bj = 0; bj < 2; ++bj) { const int rl = u.pm * BM + ai * HALF + wr * 64 + m * 16 + fr;
                    gv[m][bj] = *(const u32x2*)(Gt + (size_t)rl * GZ + u.pn * BM + wc * 64 + bj * 32 + 8 * fq);
                    if (br) mv[m][bj] = *(const u32x4*)(Mb + (size_t)rl * DM + pc * BM + wc * 64 + bj * 32 + 8 * fq); else mv[m][bj] = (u32x4){0u, 0u, 0u, 0u}; }
            asm volatile("" ::: "memory");
#pragma unroll
            for (int m = 0; m < 4; ++m)
#pragma unroll
                for (int bj = 0; bj < 2; ++bj) {
                    const int rl = u.pm * BM + ai * HALF + wr * 64 + m * 16 + fr; const u32x2 g = gv[m][bj]; const u32x4 mm = mv[m][bj];
                    const f32x4 a0 = acc[ai][bj][m][0], a1 = acc[ai][bj][m][1];
                    u32x4 w; w.x = pk2(bflo(mm.x) + ub(g.x, 0) * a0[0], bfhi(mm.x) + ub(g.x, 1) * a0[1]); w.y = pk2(bflo(mm.y) + ub(g.x, 2) * a0[2], bfhi(mm.y) + ub(g.x, 3) * a0[3]);
                    w.z = pk2(bflo(mm.z) + ub(g.y, 0) * a1[0], bfhi(mm.z) + ub(g.y, 1) * a1[1]); w.w = pk2(bflo(mm.w) + ub(g.y, 2) * a1[2], bfhi(mm.w) + ub(g.y, 3) * a1[3]);
                    if (!dry) st16(Mb + (size_t)rl * DM + pc * BM + wc * 64 + bj * 32 + 8 * fq, w);
                }
            asm volatile("" ::: "memory");
        }
    }
};
}

struct Params { const float* in[17]; float* out; unsigned char* ws; int lo, hi; float invf[64]; };
enum { I_X = 0, I_F1N, I_F1G, I_F1U, I_F1D, I_MN, I_WIN, I_CW, I_RB, I_WB, I_WMG, I_WO, I_F2N, I_F2G, I_F2U, I_F2D, I_FN };

struct WJob { const float* src; int ld, K, N; const float* gain; bf16_t* dst; int Kdst, koff, mode, rowoff; float scale; };
DI WJob get_job(const Params& P, int l, int j) {
    WJob w; unsigned char* wl = P.ws + WS_WT + (size_t)l * WLAYER;
    w.gain = nullptr; w.koff = 0; w.mode = 0; w.rowoff = 0; w.scale = 1.f;
    if (j == 0 || j == 1 || j == 11 || j == 12) {
        const bool second = j >= 11; const bool up = (j == 1 || j == 12);
        w.src = P.in[second ? (up ? I_F2U : I_F2G) : (up ? I_F1U : I_F1G)] + (size_t)l * DM * DFF; w.ld = DFF; w.K = DM; w.N = DFF;
        w.gain = P.in[second ? I_F2N : I_F1N] + l * DM; w.dst = (bf16_t*)(wl + (second ? WO6 : WO1)); w.Kdst = DM; w.mode = 1; w.rowoff = up ? 128 : 0;
    } else if (j == 2 || j == 13) {
        w.src = P.in[j == 2 ? I_F1D : I_F2D] + (size_t)l * DFF * DM; w.ld = DM; w.K = DFF; w.N = DM; w.dst = (bf16_t*)(wl + (j == 2 ? WO2 : WO7)); w.Kdst = DFF;
    } else if (j == 3) {
        w.src = P.in[I_WIN] + (size_t)l * DM * INC; w.ld = INC; w.K = DM; w.N = INC; w.gain = P.in[I_MN] + l * DM; w.dst = (bf16_t*)(wl + WO3); w.Kdst = DM; w.mode = 2;
    } else if (j >= 4 && j <= 6) {
        const int i = j - 4; w.src = P.in[I_WMG] + (size_t)(l * 3 + i) * DM * DM; w.ld = DM; w.K = DM; w.N = DM; w.gain = P.in[I_MN] + l * DM; w.dst = (bf16_t*)(wl + WO3); w.Kdst = DM; w.rowoff = INC + i * DM;
    } else if (j >= 7 && j <= 9) {
        const int i = j - 7; w.src = P.in[I_WB] + (size_t)(l * 3 + i) * 512 * DM; w.ld = DM; w.K = 512; w.N = DM; w.dst = (bf16_t*)(wl + WO4); w.Kdst = 512; w.rowoff = i * DM; w.scale = 1.f / 255.f;
    } else {
        w.src = P.in[I_WO] + (size_t)l * DM * DM; w.ld = DM; w.K = DM; w.N = DM; w.dst = (bf16_t*)(wl + WO5); w.Kdst = DM;
    }
    return w;
}
DI void wt_tile(const WJob& w, int tile, LAS float* scr, int lane) {
    const int nbn = w.N / 32, kb = tile / nbn, nb = tile % nbn, k0 = kb * 64, n0 = nb * 32;
    float scale = w.scale;
    if (w.mode == 2) { if (n0 >= 1536 && n0 < 2048) scale = 0.08838834764831845f; else if (n0 >= 3584 && n0 < 4096) scale = 0.125f * LOG2E; }
    f32x4 v[8];
#pragma unroll
    for (int i = 0; i < 8; ++i) { const int kk = i * 8 + (lane >> 3); v[i] = *(const f32x4*)(w.src + (size_t)(k0 + kk) * w.ld + n0 + 4 * (lane & 7)); }
#pragma unroll
    for (int i = 0; i < 8; ++i) { const int kk = i * 8 + (lane >> 3); const float gsc = scale * (w.gain ? w.gain[k0 + kk] : 1.f); LAS float* d = scr + kk * 33 + 4 * (lane & 7);
        d[0] = v[i].x * gsc; d[1] = v[i].y * gsc; d[2] = v[i].z * gsc; d[3] = v[i].w * gsc; }
    asm volatile("s_waitcnt lgkmcnt(0)" ::: "memory");
#pragma unroll
    for (int q = 0; q < 4; ++q) { const int item = q * 64 + lane, n = item >> 3, kc = item & 7, ng = n0 + n; int row;
      if (w.mode == 1) row = (ng >> 7) * 256 + ((ng & 127) >> 5) * 64 + (w.rowoff ? 32 : 0) + (ng & 31);
      else if (w.mode == 2 && (ng < 512 || (ng >= 1024 && ng < 1536))) {
          const int cc_ = ng >= 1024, n5 = ng & 511, zt = n5 >> 7, w7 = n5 & 127; row = (zt < 2 ? zt : zt + 2) * 256 + 64 * (w7 >> 5) + 32 * cc_ + (w7 & 31); }
      else if (w.mode == 2 && ng >= 1536 && ng < 2560) { const int pnn = ng >> 8, cl = ng & 255, hh = cl >> 7, d = cl & 127; const int bjj = d >> 6, dd = d & 63; row = pnn * 256 + 64 * (2 * hh + (dd >> 5)) + 32 * bjj + (dd & 31); }
      else row = w.rowoff + ng;
      const LAS float* s = scr + (8 * kc) * 33 + n;
      u32x4 o; o.x = pk2(s[0], s[33]); o.y = pk2(s[2 * 33], s[3 * 33]); o.z = pk2(s[4 * 33], s[5 * 33]); o.w = pk2(s[6 * 33], s[7 * 33]);
      *(u32x4*)(w.dst + (size_t)row * w.Kdst + w.koff + k0 + 8 * kc) = o; }
    asm volatile("s_waitcnt lgkmcnt(0)" ::: "memory");
}
DI float wave_sum(float v) {
#pragma unroll
    for (int o = 1; o < 64; o <<= 1) v += __shfl_xor(v, o);
    return v;
}
DI void prologue(const Params& P, LAS unsigned char* lds) {
    const int tid = otid(), lane = tid & 63, wid = tid >> 6, G = gridDim.x;
    LAS float* scr = (LAS float*)lds + wid * (64 * 33);
    for (int l = 0; l < 2; ++l)
        for (int j = 0; j < 14; ++j) { const WJob w = get_job(P, l, j); const int ntile = (w.K / 64) * (w.N / 32);
            for (int t = obid() * 8 + wid; t < ntile; t += G * 8) wt_tile(w, t, scr, lane); }
    if (blockIdx.x == 0) { unsigned* bw = (unsigned*)(P.ws + WS_BAR); for (int i = tid; i < XCD_BAR_WORDS; i += 512) bw[i] = 0u; }
    const float* x = P.in[I_X]; bf16_t* xb = (bf16_t*)(P.ws + WS_XB); float* ssq = (float*)(P.ws + WS_SSQ);
    for (int row0 = (obid() * 8 + wid) * 4; row0 < MTOK; row0 += G * 32) {
        f32x4 v[4][4];
#pragma unroll
        for (int q = 0; q < 4; ++q)
#pragma unroll
            for (int j = 0; j < 4; ++j) v[q][j] = ((const f32x4*)(x + (size_t)(row0 + q) * DM) + lane)[64 * j];
#pragma unroll
        for (int q = 0; q < 4; ++q) { float sq = 0.f; u32x2* o8 = (u32x2*)(xb + (size_t)(row0 + q) * DM) + lane;
#pragma unroll
            for (int j = 0; j < 4; ++j) { const f32x4 t = v[q][j]; sq += (t.x * t.x + t.y * t.y) + (t.z * t.z + t.w * t.w); u32x2 o; o.x = pk2(t.x, t.y); o.y = pk2(t.z, t.w); o8[64 * j] = o; }
            sq = wave_sum(sq);
            if (lane < 16) ssq[(size_t)(row0 + q) * 16 + lane] = lane == 0 ? sq : 0.f; }
    }
    float* cosT = (float*)(P.ws + WS_COS); float* sinT = (float*)(P.ws + WS_SIN);
    for (int idx = obid() * 512 + tid; idx < SEQ * 64; idx += G * 512) {
        const int pos = idx >> 6, i = idx & 63;
        const float ang = (float)pos * P.invf[i];
        const double rev = (double)ang * 0.15915494309189535; const float fr = (float)(rev - floor(rev));
        cosT[idx] = __builtin_amdgcn_cosf(fr); sinT[idx] = __builtin_amdgcn_sinf(fr);
    }
}

DI void conv_phase(const Params& P, int l, int dry = 0) {
    bf16_t* cols = (bf16_t*)(P.ws + WS_COLS); const float* cw = P.in[I_CW] + l * 3 * 512;
    const int gt = obid() * 512 + otid(), stride = gridDim.x * 512;
    for (int it = gt; it < (HROWS / 8) * 64; it += stride) {
        const int cg8 = it & 63, t0 = (it >> 6) * 8, ch = cg8 * 8;
        float w0[8], w1[8], w2[8], z1[8], z2[8];
#pragma unroll
        for (int e = 0; e < 8; ++e) { w0[e] = cw[ch + e]; w1[e] = cw[512 + ch + e]; w2[e] = cw[1024 + ch + e]; z1[e] = 0.f; z2[e] = 0.f; }
        if ((t0 & (SEQ - 1)) != 0) {
            const u32x4 a1 = *(const u32x4*)(cols + (size_t)(t0 - 1) * INC + ch), a2 = *(const u32x4*)(cols + (size_t)(t0 - 2) * INC + ch);
#pragma unroll
            for (int e = 0; e < 4; ++e) { z1[2 * e] = bflo(a1[e]); z1[2 * e + 1] = bfhi(a1[e]); z2[2 * e] = bflo(a2[e]); z2[2 * e + 1] = bfhi(a2[e]); }
        }
        u32x4 zz[8], bb[8];
#pragma unroll
        for (int q = 0; q < 8; ++q) { const bf16_t* rp = cols + (size_t)(t0 + q) * INC + ch; zz[q] = *(const u32x4*)rp; bb[q] = *(const u32x4*)(rp + 512); }
        asm volatile("" ::: "memory");
#pragma unroll
        for (int q = 0; q < 8; ++q) {
            float y[8];
#pragma unroll
            for (int e = 0; e < 4; ++e) {
                const float za = bflo(zz[q][e]), zb = bfhi(zz[q][e]);
                y[2 * e] = bflo(bb[q][e]) * (w0[2 * e] * z2[2 * e] + w1[2 * e] * z1[2 * e] + w2[2 * e] * za);
                y[2 * e + 1] = bfhi(bb[q][e]) * (w0[2 * e + 1] * z2[2 * e + 1] + w1[2 * e + 1] * z1[2 * e + 1] + w2[2 * e + 1] * zb);
                z2[2 * e] = z1[2 * e]; z2[2 * e + 1] = z1[2 * e + 1]; z1[2 * e] = za; z1[2 * e + 1] = zb;
            }
            u32x4 o; o.x = pk2(y[0], y[1]); o.y = pk2(y[2], y[3]); o.z = pk2(y[4], y[5]); o.w = pk2(y[6], y[7]);
            if (!dry) *(u32x4*)(cols + (size_t)(t0 + q) * INC + 512 + ch) = o;
        }
    }
}

constexpr int RS = 136;
DI float ret_lg(int hh) { return log2f(1.0f - exp2f(-5.0f - (float)hh)); }
DI void ret_local_unit(const Params& P, LAS unsigned char* lds, int unit) {
    const int tid = otid(), wid = tid >> 6, lane = tid & 63, r = lane & 31, h = lane >> 5;
    const int bl = unit >> 6, hh = (unit >> 4) & 3, seg = unit & 15, rowbase = bl * SEQ + seg * 512;
    const bf16_t* cols = (const bf16_t*)(P.ws + WS_COLS); float* T = (float*)(P.ws + WS_T) + (size_t)unit * 16384;
    LAS bf16_t* Ks = (LAS bf16_t*)lds; LAS bf16_t* Vs = Ks + 64 * RS;
    const float lg = ret_lg(hh);
    const int a = wid >> 1, b0 = (wid & 1) * 2, tg = (lane >> 4) & 1, tq = (lane & 15) >> 2, tp = lane & 3;
    f32x16 acc[2];
#pragma unroll
    for (int i = 0; i < 16; ++i) { acc[0][i] = 0.f; acc[1][i] = 0.f; }
    u32x4 pk[2], pv[2];
#pragma unroll
    for (int e = 0; e < 2; ++e) { const int idx = tid + 512 * e, row = idx >> 4, sg = idx & 15; const bf16_t* gp = cols + (size_t)(rowbase + row) * INC + hh * 128 + sg * 8;
        pk[e] = *(const u32x4*)(gp + 2048); pv[e] = *(const u32x4*)(gp + 2560); }
    for (int c = 0; c < 8; ++c) {
        __syncthreads();
#pragma unroll
        for (int e = 0; e < 2; ++e) { const int idx = tid + 512 * e, row = idx >> 4, sg = idx & 15;
            const u32x4 kv = pk[e], vv = pv[e];
            if (c + 1 < 8) { const bf16_t* gp = cols + (size_t)(rowbase + (c + 1) * 64 + row) * INC + hh * 128 + sg * 8; pk[e] = *(const u32x4*)(gp + 2048); pv[e] = *(const u32x4*)(gp + 2560); }
            const float sc = ex2(lg * (float)(511 - (c * 64 + row)));
            u32x4 ks; ks.x = pk2(bflo(kv.x) * sc, bfhi(kv.x) * sc); ks.y = pk2(bflo(kv.y) * sc, bfhi(kv.y) * sc); ks.z = pk2(bflo(kv.z) * sc, bfhi(kv.z) * sc); ks.w = pk2(bflo(kv.w) * sc, bfhi(kv.w) * sc);
            *(LAS u32x4*)(Ks + row * RS + sg * 8) = ks; *(LAS u32x4*)(Vs + row * RS + sg * 8) = vv; }
        __syncthreads();
#pragma unroll
        for (int s = 0; s < 4; ++s) {
            const int tr0 = (16 * s + 8 * h + tq) * RS + 16 * tg + 4 * tp;
            const bf16x8 af = cat8(trd(Ks + tr0 + 32 * a), trd(Ks + tr0 + 4 * RS + 32 * a));
            const bf16x8 bf0 = cat8(trd(Vs + tr0 + 32 * b0), trd(Vs + tr0 + 4 * RS + 32 * b0)), bf1 = cat8(trd(Vs + tr0 + 32 * (b0 + 1)), trd(Vs + tr0 + 4 * RS + 32 * (b0 + 1)));
            acc[0] = MFMA32(af, bf0, acc[0]); acc[1] = MFMA32(af, bf1, acc[1]);
        }
    }
#pragma unroll
    for (int bb = 0; bb < 2; ++bb)
#pragma unroll
        for (int i = 0; i < 16; ++i) T[(size_t)(32 * a + crow(i, h)) * 128 + 32 * (b0 + bb) + r] = acc[bb][i];
}
DI void ret_scan_unit(const Params& P, LAS unsigned char* lds, int unit, int dry = 0) {
    const int tid = otid(), wid = tid >> 6, lane = tid & 63, r = lane & 31, h = lane >> 5;
    const int bl = unit >> 6, hh = (unit >> 4) & 3, seg = unit & 15, rowbase = bl * SEQ + seg * 512;
    bf16_t* cols = (bf16_t*)(P.ws + WS_COLS); const float* T = (const float*)(P.ws + WS_T);
    LAS bf16_t* Qs = (LAS bf16_t*)lds; LAS bf16_t* Ks = Qs + 64 * RS; LAS bf16_t* Kd = Ks + 64 * RS; LAS bf16_t* Vs = Kd + 64 * RS; LAS bf16_t* St = Vs + 64 * RS;
    LAS float* red = (LAS float*)(St + 128 * RS);
    const float lg = ret_lg(hh);
    const int a = wid >> 1, b0 = (wid & 1) * 2, nt = wid >> 2, vt = wid & 3, tg = (lane >> 4) & 1, tq = (lane & 15) >> 2, tp = lane & 3;
    f32x16 Sacc[2];
#pragma unroll
    for (int i = 0; i < 16; ++i) { Sacc[0][i] = 0.f; Sacc[1][i] = 0.f; }
    for (int p = 0; p < seg; ++p) {
        const float f = exp2f(lg * 512.0f * (float)(seg - 1 - p)); const float* Tp = T + (size_t)(unit - seg + p) * 16384;
#pragma unroll
        for (int bb = 0; bb < 2; ++bb)
#pragma unroll
            for (int i = 0; i < 16; ++i) Sacc[bb][i] += f * Tp[(size_t)(32 * a + crow(i, h)) * 128 + 32 * (b0 + bb) + r];
    }
    const float g64 = exp2f(lg * 64.0f);
    u32x4 pq[2], pk[2], pv[2];
#pragma unroll
    for (int e = 0; e < 2; ++e) { const int idx = tid + 512 * e, row = idx >> 4, sg = idx & 15; const bf16_t* gp = cols + (size_t)(rowbase + row) * INC + hh * 128 + sg * 8;
        pq[e] = *(const u32x4*)(gp + 1536); pk[e] = *(const u32x4*)(gp + 2048); pv[e] = *(const u32x4*)(gp + 2560); }
    __syncthreads();
    for (int c = 0; c < 8; ++c) {
#pragma unroll
        for (int bb = 0; bb < 2; ++bb)
#pragma unroll
            for (int g4 = 0; g4 < 4; ++g4) { u32x2 w; w.x = pk2(Sacc[bb][4 * g4], Sacc[bb][4 * g4 + 1]); w.y = pk2(Sacc[bb][4 * g4 + 2], Sacc[bb][4 * g4 + 3]);
                *(LAS u32x2*)(St + (32 * (b0 + bb) + r) * RS + 32 * a + 8 * g4 + 4 * h) = w; }
#pragma unroll
        for (int e = 0; e < 2; ++e) { const int idx = tid + 512 * e, row = idx >> 4, sg = idx & 15;
            const u32x4 qv = pq[e], kv = pk[e], vv = pv[e];
            const float sc = ex2(lg * (float)(63 - row));
            u32x4 ks; ks.x = pk2(bflo(kv.x) * sc, bfhi(kv.x) * sc); ks.y = pk2(bflo(kv.y) * sc, bfhi(kv.y) * sc); ks.z = pk2(bflo(kv.z) * sc, bfhi(kv.z) * sc); ks.w = pk2(bflo(kv.w) * sc, bfhi(kv.w) * sc);
            *(LAS u32x4*)(Qs + row * RS + sg * 8) = qv; *(LAS u32x4*)(Ks + row * RS + sg * 8) = kv; *(LAS u32x4*)(Kd + row * RS + sg * 8) = ks; *(LAS u32x4*)(Vs + row * RS + sg * 8) = vv; }
        __syncthreads();
        if (c + 1 < 8) {
#pragma unroll
            for (int e = 0; e < 2; ++e) { const int idx = tid + 512 * e, row = idx >> 4, sg = idx & 15; const bf16_t* gp = cols + (size_t)(rowbase + (c + 1) * 64 + row) * INC + hh * 128 + sg * 8;
                pq[e] = *(const u32x4*)(gp + 1536); pk[e] = *(const u32x4*)(gp + 2048); pv[e] = *(const u32x4*)(gp + 2560); }
        }
        f32x16 pT[2];
#pragma unroll
        for (int i = 0; i < 16; ++i) { pT[0][i] = 0.f; pT[1][i] = 0.f; }
#pragma unroll
        for (int ks = 0; ks < 8; ++ks) {
            const bf16x8 qf = *(const LAS bf16x8*)(Qs + (32 * nt + r) * RS + 16 * ks + 8 * h);
            const bf16x8 k0 = *(const LAS bf16x8*)(Ks + r * RS + 16 * ks + 8 * h), k1 = *(const LAS bf16x8*)(Ks + (32 + r) * RS + 16 * ks + 8 * h);
            pT[0] = MFMA32(k0, qf, pT[0]); pT[1] = MFMA32(k1, qf, pT[1]);
        }
        const int nq = 32 * nt + r;
#pragma unroll
        for (int mt = 0; mt < 2; ++mt)
#pragma unroll
            for (int i = 0; i < 16; ++i) { const int mm = 32 * mt + crow(i, h); const int dd = nq > mm ? nq - mm : mm - nq; pT[mt][i] *= ex2(lg * (float)dd); }
        f32x16 O1, O2;
#pragma unroll
        for (int i = 0; i < 16; ++i) { O1[i] = 0.f; O2[i] = 0.f; }
#pragma unroll
        for (int mt = 0; mt < 2; ++mt)
#pragma unroll
            for (int s = 0; s < 2; ++s) {
                const bf16x8 af = pack8(pT[mt][8 * s], pT[mt][8 * s + 1], pT[mt][8 * s + 2], pT[mt][8 * s + 3], pT[mt][8 * s + 4], pT[mt][8 * s + 5], pT[mt][8 * s + 6], pT[mt][8 * s + 7]);
                const int tr0 = (32 * mt + 16 * s + 4 * h + tq) * RS + 32 * vt + 16 * tg + 4 * tp;
                const bf16x8 bf = cat8(trd(Vs + tr0), trd(Vs + tr0 + 8 * RS));
                O1 = MFMA32(af, bf, O1);
            }
#pragma unroll
        for (int ks = 0; ks < 8; ++ks) {
            const bf16x8 qf = *(const LAS bf16x8*)(Qs + (32 * nt + r) * RS + 16 * ks + 8 * h);
            const bf16x8 sf = *(const LAS bf16x8*)(St + (32 * vt + r) * RS + 16 * ks + 8 * h);
            O2 = MFMA32(qf, sf, O2);
        }
#pragma unroll
        for (int i = 0; i < 16; ++i) { const int n = 32 * nt + crow(i, h); O1[i] += ex2(lg * (float)(n + 1)) * O2[i]; }
#pragma unroll
        for (int i = 0; i < 16; ++i) { float v = O1[i] * O1[i];
            v += __builtin_bit_cast(float, __builtin_amdgcn_update_dpp(0, __builtin_bit_cast(int, v), 0xB1, 0xf, 0xf, false));
            v += __builtin_bit_cast(float, __builtin_amdgcn_update_dpp(0, __builtin_bit_cast(int, v), 0x4E, 0xf, 0xf, false));
            v += __builtin_bit_cast(float, __builtin_amdgcn_update_dpp(0, __builtin_bit_cast(int, v), 0x141, 0xf, 0xf, false));
            v += __builtin_bit_cast(float, __builtin_amdgcn_update_dpp(0, __builtin_bit_cast(int, v), 0x140, 0xf, 0xf, false));
            v += __shfl_xor(v, 16);
            if (r == 0) red[(32 * nt + crow(i, h)) * 4 + vt] = v; }
        bf16_t gq[16];
#pragma unroll
        for (int i = 0; i < 16; ++i) gq[i] = cols[(size_t)(rowbase + c * 64 + 32 * nt + crow(i, h)) * INC + 3072 + hh * 128 + 32 * vt + r];
#pragma unroll
        for (int i = 0; i < 16; ++i) { Sacc[0][i] *= g64; Sacc[1][i] *= g64; }
#pragma unroll
        for (int s = 0; s < 4; ++s) {
            const int tr0 = (16 * s + 8 * h + tq) * RS + 16 * tg + 4 * tp;
            const bf16x8 af = cat8(trd(Kd + tr0 + 32 * a), trd(Kd + tr0 + 4 * RS + 32 * a));
            const bf16x8 bf0 = cat8(trd(Vs + tr0 + 32 * b0), trd(Vs + tr0 + 4 * RS + 32 * b0)), bf1 = cat8(trd(Vs + tr0 + 32 * (b0 + 1)), trd(Vs + tr0 + 4 * RS + 32 * (b0 + 1)));
            Sacc[0] = MFMA32(af, bf0, Sacc[0]); Sacc[1] = MFMA32(af, bf1, Sacc[1]);
        }
        __syncthreads();
#pragma unroll
        for (int i = 0; i < 16; ++i) { const int n = 32 * nt + crow(i, h); const f32x4 q = *(const LAS f32x4*)(red + n * 4);
            const float rn = __builtin_amdgcn_rsqf(((q.x + q.y) + (q.z + q.w)) * (1.f / 128.f) + EPS);
            bf16_t* gp = cols + (size_t)(rowbase + c * 64 + n) * INC + 3072 + hh * 128 + 32 * vt + r;
            const float gv = bf2f(gq[i]); const bf16_t yv = f2bf(gv * sigm(gv) * O1[i] * rn); if (!dry) *gp = yv; }
    }
}

constexpr int ATT_BIAS_OFF = 0, ATT_SCR_OFF = 8704, ATT_T_OFF = 10240, ATT_WAVE_BYTES = 16384;
DI void att_dma_tile(const bf16_t* gsrc, LAS unsigned char* tile, int lane) {
#pragma unroll
    for (int e = 0; e < 8; ++e) { const int row = e * 8 + (lane >> 3), pos = lane & 7;
        __builtin_amdgcn_global_load_lds((const unsigned*)(gsrc + (size_t)row * INC + ((pos ^ (row & 7)) << 3)), (LAS unsigned*)(tile + e * 1024), 16, 0, 0); }
}
DI void attn_unit(bf16_t* cols, LAS unsigned char* lds, int wid, int lane, int bl, int hh, int c, int dry) {
    const int r = lane & 31, h = lane >> 5, tg = (lane >> 4) & 1, tq = (lane & 15) >> 2, tp = lane & 3;
    const LAS float* bt = (const LAS float*)(lds + ATT_BIAS_OFF) + hh * 264;
    LAS float* scr = (LAS float*)(lds + ATT_SCR_OFF) + wid * 32;
    LAS unsigned char* Kt = lds + ATT_T_OFF + wid * ATT_WAVE_BYTES; LAS unsigned char* Vt = Kt + 8192;
    const int seqbase = bl * SEQ, tq0 = seqbase + c * 64;
    const int j0 = c >= 8 ? 0 : 8 - c;
    { const bf16_t* kb = cols + (size_t)(seqbase + (c - 8 + j0) * 64) * INC + 4096 + hh * 64; att_dma_tile(kb, Kt, lane); att_dma_tile(kb + 512, Vt, lane); }
    bf16x8 qf[2][4];
#pragma unroll
    for (int qt = 0; qt < 2; ++qt)
#pragma unroll
        for (int d0 = 0; d0 < 4; ++d0) qf[qt][d0] = *(const bf16x8*)(cols + (size_t)(tq0 + 32 * qt + r) * INC + 3584 + hh * 64 + 16 * d0 + 8 * h);
    float mrow[2] = {-1e30f, -1e30f}, lsum[2] = {0.f, 0.f};
    f32x16 O[2][2];
#pragma unroll
    for (int i = 0; i < 16; ++i) { O[0][0][i] = 0.f; O[0][1][i] = 0.f; O[1][0][i] = 0.f; O[1][1][i] = 0.f; }
    for (int j = j0; j <= 8; ++j) {
        const bf16_t* kbn = cols + (size_t)(seqbase + (c - 7 + j) * 64) * INC + 4096 + hh * 64;
        asm volatile("s_waitcnt vmcnt(8)" ::: "memory");
        bf16x8 kf[2][4];
#pragma unroll
        for (int t = 0; t < 2; ++t)
#pragma unroll
            for (int d0 = 0; d0 < 4; ++d0) { const int row = 32 * t + r, ch = 2 * d0 + h; kf[t][d0] = *(const LAS bf16x8*)(Kt + row * 128 + ((ch ^ (row & 7)) << 4)); }
        asm volatile("s_waitcnt lgkmcnt(0)" ::: "memory");
        if (j < 8) att_dma_tile(kbn, Kt, lane);
        asm volatile("" ::: "memory");
        bf16x8 pf[2][4];
#pragma unroll
        for (int qt = 0; qt < 2; ++qt) {
            const int n = 32 * qt + r;
            f32x16 sT[2];
            { const float b = j <= 5 ? bt[256] : 0.f;
#pragma unroll
              for (int i = 0; i < 16; ++i) { sT[0][i] = b; sT[1][i] = b; } }
#pragma unroll
            for (int d0 = 0; d0 < 4; ++d0) { sT[0] = MFMA32(kf[0][d0], qf[qt][d0], sT[0]); sT[1] = MFMA32(kf[1][d0], qf[qt][d0], sT[1]); }
            if (j > 5) {
#pragma unroll
                for (int t = 0; t < 2; ++t)
#pragma unroll
                    for (int i = 0; i < 16; ++i) { const int mm = 32 * t + crow(i, h); int dist = 64 * (8 - j) + n - mm; dist = dist > 128 ? 128 : dist; sT[t][i] += bt[dist + 128]; }
            }
            float mx = fmaxf(sT[0][0], sT[1][0]);
#pragma unroll
            for (int i = 1; i < 16; ++i) mx = fmaxf(mx, fmaxf(sT[0][i], sT[1][i]));
            mx = fmaxf(mx, __shfl_xor(mx, 32));
            if (__any(mx > mrow[qt])) {
                const float mnew = fmaxf(mrow[qt], mx), alpha = ex2(mrow[qt] - mnew); mrow[qt] = mnew; lsum[qt] *= alpha;
                if (h == 0) scr[r] = alpha;
                asm volatile("s_waitcnt lgkmcnt(0)" ::: "memory");
#pragma unroll
                for (int g4 = 0; g4 < 4; ++g4) { const f32x4 a4 = *(const LAS f32x4*)(scr + 8 * g4 + 4 * h);
#pragma unroll
                    for (int e = 0; e < 4; ++e) { O[qt][0][4 * g4 + e] *= a4[e]; O[qt][1][4 * g4 + e] *= a4[e]; } }
                asm volatile("s_waitcnt lgkmcnt(0)" ::: "memory");
            }
            float ls = 0.f;
#pragma unroll
            for (int t = 0; t < 2; ++t)
#pragma unroll
                for (int i = 0; i < 16; ++i) { const float p = ex2(sT[t][i] - mrow[qt]); sT[t][i] = p; ls += p; }
            lsum[qt] += ls;
#pragma unroll
            for (int t = 0; t < 2; ++t)
#pragma unroll
                for (int s2 = 0; s2 < 2; ++s2)
                    pf[qt][2 * t + s2] = pack8(sT[t][8 * s2], sT[t][8 * s2 + 1], sT[t][8 * s2 + 2], sT[t][8 * s2 + 3], sT[t][8 * s2 + 4], sT[t][8 * s2 + 5], sT[t][8 * s2 + 6], sT[t][8 * s2 + 7]);
        }
        if (j < 8) asm volatile("s_waitcnt vmcnt(8)" ::: "memory"); else asm volatile("s_waitcnt vmcnt(0)" ::: "memory");
#pragma unroll
        for (int t = 0; t < 2; ++t)
#pragma unroll
            for (int s2 = 0; s2 < 2; ++s2) {
                const int row = 32 * t + 16 * s2 + 4 * h + tq;
#pragma unroll
                for (int dh = 0; dh < 2; ++dh) {
                    const int ch = 4 * dh + 2 * tg + (tp >> 1), off = (((ch ^ (row & 7)) << 4) + ((tp & 1) << 3));
                    const bf16x8 bf = cat8(trd((const LAS bf16_t*)(Vt + row * 128 + off)), trd((const LAS bf16_t*)(Vt + (row + 8) * 128 + off)));
                    O[0][dh] = MFMA32(pf[0][2 * t + s2], bf, O[0][dh]); O[1][dh] = MFMA32(pf[1][2 * t + s2], bf, O[1][dh]);
                }
            }
        asm volatile("s_waitcnt lgkmcnt(0)" ::: "memory");
        if (j < 8) att_dma_tile(kbn + 512, Vt, lane);
        asm volatile("" ::: "memory");
    }
#pragma unroll
    for (int qt = 0; qt < 2; ++qt) {
        float l = lsum[qt]; l += __shfl_xor(l, 32);
        if (h == 0) scr[r] = l;
        asm volatile("s_waitcnt lgkmcnt(0)" ::: "memory");
#pragma unroll
        for (int i = 0; i < 16; ++i) { const int q = crow(i, h); const float inv = __builtin_amdgcn_rcpf(scr[q]);
            bf16_t* op = cols + (size_t)(tq0 + 32 * qt + q) * INC + 3584 + hh * 64 + r;
            const bf16_t o0 = f2bf(O[qt][0][i] * inv), o1 = f2bf(O[qt][1][i] * inv); if (!dry) { op[0] = o0; op[32] = o1; } }
        asm volatile("s_waitcnt lgkmcnt(0)" ::: "memory");
    }
}
DI void attn_phase(const Params& P, LAS unsigned char* lds, int l, int dry = 0) {
    const int tid = otid(), lane = tid & 63, wid = __builtin_amdgcn_readfirstlane(tid >> 6);
    LAS float* bias = (LAS float*)(lds + ATT_BIAS_OFF); const float* rb = P.in[I_RB] + l * 8 * 257;
    __syncthreads();
    for (int i = tid; i < 8 * 257; i += 512) bias[(i / 257) * 264 + (i % 257)] = rb[i] * LOG2E;
    __syncthreads();
    bf16_t* cols = (bf16_t*)(P.ws + WS_COLS);
    for (int u = obid() * 8 + wid; u < 4096; u += gridDim.x * 8) {
        const int c = u & 127, hh = (u >> 7) & 7, bl = u >> 10;
        attn_unit(cols, lds, wid, lane, bl, hh, c, dry);
    }
    asm volatile("s_waitcnt vmcnt(0)" ::: "memory");
    __syncthreads();
}

DI void final_norm(const Params& P, int dry = 0) {
    const int tid = otid(), lane = tid & 63, wid = tid >> 6; const float* ssq = (const float*)(P.ws + WS_SSQ); const float* w = P.in[I_FN]; const bf16_t* xb = (const bf16_t*)(P.ws + WS_XB);
    for (int row0 = (obid() * 8 + wid) * 4; row0 < MTOK; row0 += gridDim.x * 32) {
        u32x4 xv[4][2]; float rs[4];
#pragma unroll
        for (int q = 0; q < 4; ++q) { rs[q] = row_rstd(ssq, row0 + q);
#pragma unroll
            for (int j = 0; j < 2; ++j) xv[q][j] = *(const u32x4*)(xb + (size_t)(row0 + q) * DM + 512 * j + 8 * lane); }
#pragma unroll
        for (int q = 0; q < 4; ++q)
#pragma unroll
            for (int j = 0; j < 2; ++j) {
                const int c0 = 512 * j + 8 * lane; const u32x4 t = xv[q][j];
                const f32x4 g0 = *(const f32x4*)(w + c0), g1 = *(const f32x4*)(w + c0 + 4);
                const f32x4 o0 = (f32x4){bflo(t.x), bfhi(t.x), bflo(t.y), bfhi(t.y)} * rs[q] * g0, o1 = (f32x4){bflo(t.z), bfhi(t.z), bflo(t.w), bfhi(t.w)} * rs[q] * g1;
                if (!dry) { *(f32x4*)(P.out + (size_t)(row0 + q) * DM + c0) = o0; *(f32x4*)(P.out + (size_t)(row0 + q) * DM + c0 + 4) = o1; }
            }
    }
}

#define XB_TMO      128
#define XB_XCNT(j)  (256  + 64 * (j))
#define XB_XSUB(j)  (1280 + 64 * (j))
#define XB_XGEN(j)  (2304 + 64 * (j))
#define XB_TOP      3328
#define XB_TOPGEN   3392
#define XB_SPIN_CAP (1u << 22)
DI unsigned xb_ld(unsigned* p)              { return __hip_atomic_load(p, __ATOMIC_RELAXED, __HIP_MEMORY_SCOPE_AGENT); }
DI unsigned xb_add(unsigned* p, unsigned v) { return __hip_atomic_fetch_add(p, v, __ATOMIC_RELAXED, __HIP_MEMORY_SCOPE_AGENT); }
DI unsigned xb_xcc_id() { return (unsigned)__builtin_amdgcn_s_getreg((3 << 11) | 20) & 0xFu; }
#define XB_SPIN(cond, bar) do { unsigned _sp = 0; while (cond) { __builtin_amdgcn_s_sleep(1); \
    if ((++_sp & 255u) == 0u) { if (xb_ld(&(bar)[XB_TMO])) break; if (_sp > XB_SPIN_CAP) { atomicAdd(&(bar)[XB_TMO], 1u); break; } } } } while (0)
struct XcdBarrier { unsigned* bar; unsigned x; volatile LAS unsigned* st; };
DI XcdBarrier xcd_barrier_post(unsigned* bar, volatile LAS unsigned* st) {
    XcdBarrier b; b.bar = bar; b.x = xb_xcc_id(); b.st = st;
    if (threadIdx.x == 0) (void)xb_add(&bar[XB_XCNT(b.x)], 1u);
    return b;
}
DI void xcd_barrier_complete(unsigned* bar, unsigned x, unsigned& nloc, unsigned& nx) {
    const unsigned G = gridDim.x * gridDim.y * gridDim.z;
    unsigned sum, cnt, mine, sp = 0u;
    for (;;) {
        sum = 0u; cnt = 0u; mine = 0u;
#pragma unroll
        for (unsigned j = 0; j < 16; ++j) { const unsigned c = xb_ld(&bar[XB_XCNT(j)]); sum += c; cnt += (c > 0u) ? 1u : 0u; mine = (j == x) ? c : mine; }
        if (sum == G) break;
        __builtin_amdgcn_s_sleep(1);
        if ((++sp & 255u) == 0u) { if (xb_ld(&bar[XB_TMO])) break; if (sp > XB_SPIN_CAP) { atomicAdd(&bar[XB_TMO], 1u); break; } }
    }
    nloc = mine > 0u ? mine : 1u; nx = cnt > 0u ? cnt : 1u;
}
DI void xcd_barrier(const XcdBarrier& b) {
    asm volatile("s_waitcnt vmcnt(0)" ::: "memory");
    __syncthreads();
    if (threadIdx.x == 0) {
        unsigned* bar = b.bar;
        __builtin_amdgcn_s_waitcnt(0);
        unsigned nloc = b.st[0], nx = b.st[1];
        if (nloc == 0u) { xcd_barrier_complete(bar, b.x, nloc, nx); b.st[0] = nloc; b.st[1] = nx; }
        const unsigned old = xb_add(&bar[XB_XSUB(b.x)], 1u);
        const unsigned gen = old / nloc;
        if (old + 1u == (gen + 1u) * nloc) {
            __builtin_amdgcn_fence(__ATOMIC_RELEASE, "agent");
            asm volatile("s_waitcnt vmcnt(0)" ::: "memory");
            const unsigned og = xb_add(&bar[XB_TOP], 1u);
            const unsigned tg = og / nx;
            if (og + 1u == (tg + 1u) * nx) xb_add(&bar[XB_TOPGEN], 1u);
            else XB_SPIN(xb_ld(&bar[XB_TOPGEN]) == tg, bar);
            __builtin_amdgcn_fence(__ATOMIC_ACQUIRE, "agent");
            xb_add(&bar[XB_XGEN(b.x)], 1u);
            asm volatile("s_waitcnt vmcnt(0)" ::: "memory");
        } else {
            XB_SPIN(xb_ld(&bar[XB_XGEN(b.x)]) == gen, bar);
            __builtin_amdgcn_fence(__ATOMIC_ACQUIRE, "agent");
            asm volatile("s_waitcnt vmcnt(0)" ::: "memory");
        }
    }
    __syncthreads();
}

constexpr int NPHASE = 30;
__global__ void __launch_bounds__(512, 2) fwd_kernel(Params Parg) {
    extern __shared__ __attribute__((aligned(16))) unsigned char lds_raw[];
    LAS unsigned char* lds = (LAS unsigned char*)lds_raw;
    const int G = gridDim.x;
    typedef const __attribute__((address_space(4))) Params* KP;
    const KP Pk = (KP)__builtin_amdgcn_kernarg_segment_ptr();
    const int ph_lo = Pk->lo, ph_hi = Pk->hi;
#define XB ((bf16_t*)(ws + WS_XB))
#define COLS ((bf16_t*)(ws + WS_COLS))
#define GB ((bf16_t*)(ws + WS_G))
#define HID ((bf16_t*)(ws + WS_HID))
#define SSQ ((float*)(ws + WS_SSQ))
    volatile LAS unsigned* MISC = (volatile LAS unsigned*)(lds + LDS_BYTES - 64);
    if (threadIdx.x < 4) MISC[threadIdx.x] = 0u;
    __syncthreads();
    XcdBarrier bar; bar.bar = (unsigned*)(Pk->ws + WS_BAR); bar.x = 0; bar.st = MISC;
    for (int ph = ph_lo; ph < ph_hi; ++ph) {
        if (ph > ph_lo) {
            if (ph == ph_lo + 1) { cg::this_grid().sync(); bar = xcd_barrier_post((unsigned*)(Pk->ws + WS_BAR), MISC); }
            else xcd_barrier(bar);
        }
        KP Pp = Pk; asm volatile("" : "+s"(Pp));
        const Params& P = *(const Params*)Pp;
        unsigned char* ws = P.ws;
        if (ph == 0) { prologue(P, lds); if (PROBE == 3) prologue(P, lds); continue; }
        if (ph == NPHASE - 1) { if (PROBE == 3) final_norm(P, P.hi != 12345); final_norm(P); continue; }
        const int l = (ph - 1) / 14, k = (ph - 1) % 14;
        unsigned char* wl = ws + WS_WT + (size_t)l * WLAYER;
        pg8::StaticOrder S;
        if (k == 0 || k == 12) {
            pg8::Gemm g{XB, (const bf16_t*)(wl + (k == 0 ? WO1 : WO6)), DM, DM, 128, 256 * DM * 2}; S.init(MTOK, 2 * DFF, G, obid());
            pg8::EpiGateUp E{HID, SSQ, 0};
#if PROBE == 11
            { pg8::EpiGateUp Ed = E; Ed.dry = (P.hi != 12345); pg8::gemm_phase<pg8::EpiGateUp>(lds, g, S, Ed); }
#endif
            for (int rep = 0; rep < (PROBE == 2 ? 2 : 1); ++rep) pg8::gemm_phase<pg8::EpiGateUp>(lds, g, S, E, STAGGER);
        } else if (k == 1 || k == 13) {
            pg8::Gemm g{HID, (const bf16_t*)(wl + (k == 1 ? WO2 : WO7)), DFF, 64, 32768, (DFF / 64) * 32768}; S.init(MTOK, DM, G, obid());
            pg8::EpiResid E{(l == 0 && k == 1) ? P.in[I_X] : (const float*)nullptr, (float*)nullptr, XB, SSQ, 0.5f, 0, 0, XB, SSQ};
#if PROBE == 9
            { pg8::EpiResid Ed = E; Ed.xout32 = nullptr; Ed.xbo = (bf16_t*)(ws + (P.hi != 12345 ? 848 * MiB : WS_XB)); Ed.ssqo = (float*)(ws + (P.hi != 12345 ? 980 * MiB : WS_SSQ)); pg8::gemm_phase<pg8::EpiResid>(lds, g, S, Ed); }
#endif
#if PROBE == 4 || PROBE == 10
            { pg8::EpiResid Ed = E; Ed.dry = (P.hi != 12345); pg8::gemm_phase<pg8::EpiResid>(lds, g, S, Ed); }
#endif
            pg8::gemm_phase<pg8::EpiResid>(lds, g, S, E);
        } else {
            const int half = (k - 2) / 5, kk = (k - 2) % 5, row0 = half * HROWS;
            if (kk == 0) {
                pg8::Gemm g{XB + (size_t)row0 * DM, (const bf16_t*)(wl + WO3), DM, DM, 128, 256 * DM * 2}; S.init(HROWS, NCAT, G, obid());
                pg8::EpiInProj E{COLS, (unsigned char*)GB, SSQ, (const float*)(ws + WS_COS), (const float*)(ws + WS_SIN), row0, 0};
#if PROBE == 11
                { pg8::EpiInProj Ed = E; Ed.dry = (P.hi != 12345); pg8::gemm_phase<pg8::EpiInProj>(lds, g, S, Ed); }
#endif
                for (int rep = 0; rep < (PROBE == 2 ? 2 : 1); ++rep) pg8::gemm_phase<pg8::EpiInProj>(lds, g, S, E, STAGGER);
            } else if (kk == 1) {
#if PROBE == 1
                if (P.hi != 12345) { for (int u = obid(); u < 256; u += G) ret_local_unit(P, lds, u); conv_phase(P, l, P.hi != 12345); }
#endif
                if (HAS(4)) { for (int u = obid(); u < 256; u += G) ret_local_unit(P, lds, u);
                conv_phase(P, l); }
            } else if (kk == 2) {
#if PROBE == 1
                if (P.hi != 12345) { for (int u = obid(); u < 256; u += G) ret_scan_unit(P, lds, u, P.hi != 12345); attn_phase(P, lds, l, P.hi != 12345); }
#endif
                if (HAS(5)) for (int u = obid(); u < 256; u += G) ret_scan_unit(P, lds, u);
                if (HAS(6)) attn_phase(P, lds, l);
            } else if (kk == 3) {
                pg8::Gemm g{COLS, (const bf16_t*)(wl + WO4), 512, INC, 128, 256 * INC * 2}; S.init(HROWS, DM, G, obid(), 1);
                pg8::EpiBranch E{(const unsigned char*)GB, (bf16_t*)(ws + WS_MB), 0};
#if PROBE == 12
                { pg8::EpiBranch Ed = E; Ed.dry = (P.hi != 12345); pg8::gemm_phase<pg8::EpiBranch, true>(lds, g, S, Ed); }
#endif
                pg8::gemm_phase<pg8::EpiBranch, true>(lds, g, S, E);
            } else {
                pg8::Gemm g{(const bf16_t*)(ws + WS_MB), (const bf16_t*)(wl + WO5), DM, DM, 128, 256 * DM * 2}; S.init(HROWS, DM, G, obid());
                pg8::EpiResid E{nullptr, nullptr, XB, SSQ, 1.0f, row0, 0, XB, SSQ};
#if PROBE == 9
                { pg8::EpiResid Ed = E; Ed.xbo = (bf16_t*)(ws + (P.hi != 12345 ? 848 * MiB : WS_XB)); Ed.ssqo = (float*)(ws + (P.hi != 12345 ? 980 * MiB : WS_SSQ)); pg8::gemm_phase<pg8::EpiResid>(lds, g, S, Ed); }
#endif
#if PROBE == 4 || PROBE == 10
                { pg8::EpiResid Ed = E; Ed.dry = (P.hi != 12345); pg8::gemm_phase<pg8::EpiResid>(lds, g, S, Ed); }
#endif
                pg8::gemm_phase<pg8::EpiResid>(lds, g, S, E);
            }
        }
    }
}

extern "C" void kernel_launch(void* const* d_in, const int* in_sizes, int n_in, void* d_out, int out_size, void* d_ws, size_t ws_size, hipStream_t stream) {
    static int grid = 0;
    if (grid == 0) {
        if (n_in != 17 || out_size != MTOK * DM || ws_size < WS_END) { fprintf(stderr, "kernel_launch: unexpected shapes (n_in %d out %d ws %zu)\n", n_in, out_size, ws_size); grid = -1; return; }
        int dev = 0, cus = 0, per_cu = 0;
        (void)hipGetDevice(&dev); (void)hipDeviceGetAttribute(&cus, hipDeviceAttributeMultiprocessorCount, dev);
        (void)hipFuncSetAttribute((const void*)fwd_kernel, hipFuncAttributeMaxDynamicSharedMemorySize, LDS_BYTES);
        if (hipOccupancyMaxActiveBlocksPerMultiprocessor(&per_cu, (const void*)fwd_kernel, 512, LDS_BYTES) != hipSuccess || per_cu < 1) per_cu = 1;
        (void)hipGetLastError();
        if (cus <= 0) cus = 256;
        grid = cus * per_cu;
    }
    if (grid < 0) return;
    Params p{};
    for (int i = 0; i < 17; ++i) p.in[i] = (const float*)d_in[i];
    p.out = (float*)d_out; p.ws = (unsigned char*)d_ws;
    for (int i = 0; i < 64; ++i) p.invf[i] = powf(10000.0f, -((float)i / 63.0f));
#if MK_MULTI
    for (int ph = 0; ph < NPHASE; ++ph) { p.lo = ph; p.hi = ph + 1; hipLaunchKernelGGL(fwd_kernel, dim3(grid), dim3(512), LDS_BYTES, stream, p); }
#else
    p.lo = 0; p.hi = NPHASE;
    void* args[] = {&p};
    hipError_t e = hipLaunchCooperativeKernel((const void*)fwd_kernel, dim3(grid), dim3(512), args, LDS_BYTES, stream);
    if (e != hipSuccess) fprintf(stderr, "cooperative launch failed: %s (grid %d)\n", hipGetErrorString(e), grid);
#endif
}
```

```cpp
#include <hip/hip_runtime.h>
#include <hip/hip_cooperative_groups.h>
#include <cstdio>
#include <cstdint>
#include <cmath>
namespace cg = cooperative_groups;

#ifndef MK_MULTI
#define MK_MULTI 0
#endif

#ifndef PROBE
#define PROBE 0
#endif
#ifndef STAGGER
#define STAGGER 0
#endif
#ifndef PH_MASK
#define PH_MASK 0x1ff
#endif
#define HAS(x) (((PH_MASK) >> (x)) & 1)
#define DI __device__ __forceinline__
#define LAS __attribute__((address_space(3)))
typedef unsigned short bf16_t;
typedef short bf16x8 __attribute__((ext_vector_type(8)));
typedef float f32x4 __attribute__((ext_vector_type(4)));
typedef float f32x16 __attribute__((ext_vector_type(16)));
typedef unsigned u32x4 __attribute__((ext_vector_type(4)));
typedef unsigned u32x2 __attribute__((ext_vector_type(2)));
typedef float f32x2_t __attribute__((ext_vector_type(2)));
typedef __bf16 bf16x2_t __attribute__((ext_vector_type(2)));

constexpr int DM = 1024, SEQ = 8192, NBATCH = 8, MTOK = NBATCH * SEQ, DFF = 2816, INC = 5120, GZ = 3072, NCAT = INC + GZ;
constexpr int HROWS = MTOK / 2;
constexpr float EPS = 1e-6f;
constexpr float LOG2E = 1.4426950408889634f;
constexpr size_t MiB = (size_t)1 << 20;
constexpr size_t WS_BAR = 0;
constexpr size_t WS_SSQ = 1 * MiB;
constexpr size_t WS_COS = 5 * MiB, WS_SIN = 7 * MiB;
constexpr size_t WS_T = 9 * MiB;
constexpr size_t WS_WT = 26 * MiB;
constexpr size_t WO1 = 0, WO2 = WO1 + (size_t)2 * DFF * DM * 2, WO3 = WO2 + (size_t)DM * DFF * 2, WO4 = WO3 + (size_t)NCAT * DM * 2,
                 WO5 = WO4 + (size_t)GZ * 512 * 2, WO6 = WO5 + (size_t)DM * DM * 2, WO7 = WO6 + (size_t)2 * DFF * DM * 2, WLAYER = WO7 + (size_t)DM * DFF * 2;
constexpr size_t WS_XB = 144 * MiB;
constexpr size_t WS_COLS = 272 * MiB;
constexpr size_t WS_G = 592 * MiB;
constexpr size_t WS_HID = 272 * MiB;
constexpr size_t WS_MB = 784 * MiB;
constexpr size_t WS_END = 848 * MiB;
static_assert(WS_WT + 2 * WLAYER <= WS_XB && WS_HID + (size_t)MTOK * DFF * 2 <= WS_END && WS_COLS + (size_t)HROWS * INC * 2 <= WS_G, "ws map");
#define XCD_BAR_WORDS 3456
constexpr int LDS_BYTES = 147456;

DI int otid() { int t = threadIdx.x; asm volatile("" : "+v"(t)); return t; }
DI int obid() { int b = blockIdx.x; asm volatile("" : "+s"(b)); return b; }
DI unsigned pk2(float lo, float hi) { f32x2_t v = {lo, hi}; bf16x2_t b = __builtin_convertvector(v, bf16x2_t); return __builtin_bit_cast(unsigned, b); }
DI float bflo(unsigned w) { return __uint_as_float(w << 16); }
DI float bfhi(unsigned w) { return __uint_as_float(w & 0xffff0000u); }
DI float bf2f(bf16_t u) { return __uint_as_float(((unsigned)u) << 16); }
DI bf16_t f2bf(float f) { return (bf16_t)(pk2(f, 0.f) & 0xffffu); }
DI float ex2(float x) { return __builtin_amdgcn_exp2f(x); }
DI float sigm(float v) { return __builtin_amdgcn_rcpf(1.f + ex2(-LOG2E * v)); }
DI unsigned q8(float g) { return (unsigned)(g * 255.f + 0.5f); }
DI unsigned pkq4(float a, float b, float c, float d) { return q8(a) | (q8(b) << 8) | (q8(c) << 16) | (q8(d) << 24); }
DI float ub(unsigned w, int k) { return (float)((w >> (8 * k)) & 0xffu); }
DI int crow(int reg, int h) { return (reg & 3) + 8 * (reg >> 2) + 4 * h; }
#define MFMA32(a, b, c) __builtin_amdgcn_mfma_f32_32x32x16_bf16((a), (b), (c), 0, 0, 0)
DI bf16x8 pack8(float a0, float a1, float a2, float a3, float a4, float a5, float a6, float a7) {
    u32x4 p; p.x = pk2(a0, a1); p.y = pk2(a2, a3); p.z = pk2(a4, a5); p.w = pk2(a6, a7); return __builtin_bit_cast(bf16x8, p);
}
typedef short v4i16_t __attribute__((ext_vector_type(4)));
DI v4i16_t trd(const LAS bf16_t* p) { return __builtin_amdgcn_ds_read_tr16_b64_v4i16((LAS v4i16_t*)p); }
DI bf16x8 cat8(v4i16_t lo, v4i16_t hi) { return __builtin_shufflevector(lo, hi, 0, 1, 2, 3, 4, 5, 6, 7); }
#ifndef NT_STORE
#define NT_STORE 0
#endif
DI void st16(void* p, u32x4 v) {
#if NT_STORE == 1
    __builtin_nontemporal_store(v, (u32x4*)p);
#elif NT_STORE == 2
    asm volatile("global_store_dwordx4 %0, %1, off sc1" :: "v"(p), "v"(v) : "memory");
#else
    *(u32x4*)p = v;
#endif
}
DI float row_rstd(const float* ssq, int grow) {
    const f32x4* p = (const f32x4*)(ssq + (size_t)grow * 16); const f32x4 a = p[0], b = p[1], c = p[2], d = p[3];
    const float s = ((a.x + a.y) + (a.z + a.w)) + ((b.x + b.y) + (b.z + b.w)) + ((c.x + c.y) + (c.z + c.w)) + ((d.x + d.y) + (d.z + d.w));
    return __builtin_amdgcn_rsqf(s * (1.f / DM) + EPS);
}

namespace pg8 {
constexpr int BM = 256, BK = 64, HALF = 128, HTB = HALF * BK * 2, STAGE_BYTES = 8 * HTB, NXCD = 8, WGM = 8;
__host__ __device__ __forceinline__ int lds_byte(int r, int c) { const int st = (r >> 4) * 2 + (c >> 5), rr = r & 15, cc = c & 31, ob = rr * 64 + cc * 2; return st * 1024 + (ob ^ (((ob >> 9) & 1) << 5)); }
__host__ __device__ __forceinline__ void stage_rc(int b, int& R, int& C) { const int st = b / 1024, sb = b % 1024, swz = sb ^ (((sb >> 9) & 1) << 5); R = (st >> 1) * 16 + swz / 64; C = (st & 1) * 32 + (swz % 64) / 2; }
__host__ __device__ __forceinline__ int perm32(int rho) { const int n = rho >> 4, i = rho & 15; return 8 * (i >> 2) + 4 * n + (i & 3); }
struct Unit { int pm, pn; };
struct Gemm { const bf16_t* A; const bf16_t* Bt; int K, lda; int kstepA, tA; };
struct StaticOrder {
    int nM, nN, nwg, G, c;
    __device__ void init(int M, int N, int G_, int c_, int br3_ = 0) { nM = M / BM; nN = N / BM; nwg = nM * nN; G = G_; c = c_; br3 = br3_; }
    int br3;
    __device__ bool next(int i, Unit& u) const {
        if (br3) { const int b = i % 3; if (!next1(i / 3, u)) return false; u.pn += b * nN; return true; }
        return next1(i, u);
    }
    __device__ bool next1(int i, Unit& u) const {
        const long L = (long)i * G + c; if (L >= nwg) return false;
        int wgid = (int)L; { const int q = nwg / NXCD, r = nwg % NXCD, xcd = wgid % NXCD, off = wgid / NXCD; wgid = (xcd < r ? xcd * (q + 1) : r * (q + 1) + (xcd - r) * q) + off; }
        const int nig = WGM * nN, gid = wgid / nig, fm = gid * WGM, gsz = (nM - fm) < WGM ? (nM - fm) : WGM;
        u.pm = fm + ((wgid % nig) % gsz); u.pn = (wgid % nig) / gsz; return true;
    }
};
template <class Epi, bool BR = false>
DI void gemm_phase(LAS unsigned char* lds, const Gemm g, const StaticOrder& S, const Epi& E, int stagger = 0) {
    const int tid = otid(), wid = __builtin_amdgcn_readfirstlane(tid >> 6), lane = tid & 63, wr = wid >> 2, wc = wid & 3, fr = lane & 15, fq = lane >> 4;
    const int K = g.K, nt = K / BK, lda = g.lda;
    unsigned voffA[2], voffB[2];
#pragma unroll
    for (int i = 0; i < 2; ++i) { int R, C; stage_rc(tid * 16 + i * 8192, R, C); const int Rb = 64 * (R >> 5) + perm32(R & 31);
        voffA[i] = (unsigned)(R * lda + C) * 2u; voffB[i] = (unsigned)(Rb * K + C) * 2u; }
    const size_t kstep = (size_t)(BK * 2);
    const size_t hA = (size_t)HALF * lda * 2, tA = (size_t)g.tA, kstepA = (size_t)g.kstepA;
    const size_t hB = (size_t)32 * K * 2, tB = (size_t)BM * K * 2;
    const unsigned ldsw = (unsigned)wid * 1024u;
    const int aoff = lds_byte(wr * 64 + fr, fq * 8), boff = lds_byte(wc * 32 + fr, fq * 8);
#define PG8_SA(b, h) (((b) * 2 + (h)) * HTB)
#define PG8_SB(b, h) ((4 + (b) * 2 + (h)) * HTB)
#define PG8_STAGE(bufoff, gbase, voff) do { _Pragma("unroll") for (int _i = 0; _i < 2; ++_i) \
        __builtin_amdgcn_global_load_lds((const unsigned*)((const char*)(gbase) + (voff)[_i]), (LAS unsigned*)(lds + (bufoff) + ldsw + _i * 8192), 16, 0, 0); } while (0)
#define PG8_LDA(dst, b, h) do { _Pragma("unroll") for (int m = 0; m < 4; ++m) _Pragma("unroll") for (int k = 0; k < 2; ++k) dst[m][k] = *(const LAS bf16x8*)(lds + PG8_SA(b, h) + aoff + m * 2048 + k * 1024); } while (0)
#define PG8_LDB(dst, b, h) do { _Pragma("unroll") for (int n = 0; n < 2; ++n) _Pragma("unroll") for (int k = 0; k < 2; ++k) dst[n][k] = *(const LAS bf16x8*)(lds + PG8_SB(b, h) + boff + n * 2048 + k * 1024); } while (0)
#define PG8_MMA(ai, bj, At, Bt) do { __builtin_amdgcn_s_setprio(1); _Pragma("unroll") for (int m = 0; m < 4; ++m) _Pragma("unroll") for (int n = 0; n < 2; ++n) _Pragma("unroll") for (int k = 0; k < 2; ++k) \
        acc[ai][bj][m][n] = __builtin_amdgcn_mfma_f32_16x16x32_bf16(Bt[n][k], At[m][k], acc[ai][bj][m][n], 0, 0, 0); __builtin_amdgcn_s_setprio(0); } while (0)
#define PG8_WAIT_V(n) asm volatile("s_waitcnt vmcnt(" #n ")" ::: "memory")
#define PG8_WAIT_L(n) asm volatile("s_waitcnt lgkmcnt(" #n ")" ::: "memory")
#define PG8_BAR __builtin_amdgcn_s_barrier()
#define PG8_SCHED __builtin_amdgcn_sched_barrier(0)
#define PG8_ACOL(u) (BR ? (((u).pn >> 2) == 0 ? 512 : (((u).pn >> 2) == 1 ? 3072 : 3584)) : 0)
    Unit cur, nxt; int ui = 0;
    if (!S.next(0, cur)) return;
    if (stagger > 0) { const unsigned cls = ((unsigned)S.c >> 3) & 3u; const unsigned long long t0 = __builtin_amdgcn_s_memrealtime();
        while (__builtin_amdgcn_s_memrealtime() - t0 < (unsigned long long)(cls * (unsigned)stagger)) __builtin_amdgcn_s_sleep(8); }
    f32x4 acc[2][2][4][2];
#pragma unroll
    for (int a = 0; a < 2; ++a)
#pragma unroll
        for (int b = 0; b < 2; ++b)
#pragma unroll
            for (int m = 0; m < 4; ++m)
#pragma unroll
                for (int n = 0; n < 2; ++n) acc[a][b][m][n] = (f32x4){0.f, 0.f, 0.f, 0.f};
    bf16x8 At[4][2], B0[2][2], B1[2][2];
    const char* cA = (const char*)g.A + (size_t)cur.pm * tA + (size_t)PG8_ACOL(cur) * 2; const char* cB = (const char*)g.Bt + (size_t)cur.pn * tB;
    PG8_STAGE(PG8_SB(0, 0), cB, voffB); PG8_STAGE(PG8_SB(0, 1), cB + hB, voffB); PG8_STAGE(PG8_SA(0, 0), cA, voffA); PG8_STAGE(PG8_SA(0, 1), cA + hA, voffA);
    if (wr == 1) PG8_BAR;
    PG8_WAIT_V(2); PG8_BAR;
    PG8_STAGE(PG8_SB(1, 0), cB + kstep, voffB); PG8_STAGE(PG8_SA(1, 0), cA + kstepA, voffA); PG8_STAGE(PG8_SB(1, 1), cB + hB + kstep, voffB);
    PG8_WAIT_V(6); PG8_BAR;
    for (;;) {
        const bool has_next = S.next(ui + 1, nxt);
        const char* nA = has_next ? (const char*)g.A + (size_t)nxt.pm * tA + (size_t)PG8_ACOL(nxt) * 2 : cA; const char* nB = has_next ? (const char*)g.Bt + (size_t)nxt.pn * tB : cB;
        for (int t = 0; t < nt; t += 2) {
            const bool last = (t == nt - 2);
            const char* a1 = cA + (size_t)(t + 1) * kstepA;
            const char* a2 = last ? nA : cA + (size_t)(t + 2) * kstepA; const char* b2 = last ? nB : cB + (size_t)(t + 2) * kstep;
            const char* a3 = a2 + kstepA; const char* b3 = b2 + kstep;
            PG8_LDB(B0, 0, 0); PG8_LDB(B1, 0, 1); PG8_SCHED; PG8_LDA(At, 0, 0); PG8_STAGE(PG8_SA(1, 1), a1 + hA, voffA);
            PG8_WAIT_V(8); PG8_WAIT_L(0); PG8_BAR; PG8_MMA(0, 0, At, B0); PG8_MMA(0, 1, At, B1); PG8_BAR; PG8_SCHED;
            PG8_LDA(At, 0, 1); PG8_STAGE(PG8_SB(0, 0), b2, voffB); PG8_STAGE(PG8_SB(0, 1), b2 + hB, voffB); PG8_STAGE(PG8_SA(0, 0), a2, voffA);
            PG8_WAIT_V(8); PG8_WAIT_L(0); PG8_BAR; PG8_MMA(1, 0, At, B0); PG8_MMA(1, 1, At, B1); PG8_BAR; PG8_SCHED;
            PG8_LDB(B0, 1, 0); PG8_LDB(B1, 1, 1); PG8_SCHED; PG8_LDA(At, 1, 0); PG8_STAGE(PG8_SA(0, 1), a2 + hA, voffA);
            PG8_WAIT_V(8); PG8_WAIT_L(0); PG8_BAR; PG8_MMA(0, 0, At, B0); PG8_MMA(0, 1, At, B1); PG8_BAR; PG8_SCHED;
            PG8_LDA(At, 1, 1); PG8_STAGE(PG8_SB(1, 0), b3, voffB); PG8_STAGE(PG8_SB(1, 1), b3 + hB, voffB); PG8_STAGE(PG8_SA(1, 0), a3, voffA);
            PG8_WAIT_V(8); PG8_WAIT_L(0); PG8_BAR; PG8_MMA(1, 0, At, B0); PG8_MMA(1, 1, At, B1); PG8_BAR; PG8_SCHED;
        }
        if (wr == 0) PG8_BAR;
        E(acc, cur, wr, wc, fr, fq);
        if (!has_next) break;
#pragma unroll
        for (int a = 0; a < 2; ++a)
#pragma unroll
            for (int b = 0; b < 2; ++b)
#pragma unroll
                for (int m = 0; m < 4; ++m)
#pragma unroll
                    for (int n = 0; n < 2; ++n) acc[a][b][m][n] = (f32x4){0.f, 0.f, 0.f, 0.f};
        cur = nxt; cA = nA; cB = nB; ++ui;
        if (wr == 1) PG8_BAR;
    }
    PG8_WAIT_V(0);
    PG8_BAR;
#undef PG8_SA
#undef PG8_SB
#undef PG8_STAGE
#undef PG8_LDA
#undef PG8_LDB
#undef PG8_MMA
#undef PG8_WAIT_V
#undef PG8_WAIT_L
#undef PG8_BAR
#undef PG8_SCHED
#undef PG8_ACOL
}

struct EpiGateUp {
    bf16_t* H; const float* ssq; int dry;
    DI void operator()(const f32x4 (&acc)[2][2][4][2], const Unit& u, int wr, int wc, int fr, int fq) const {
        const int lane = fr + 16 * fq;
        const float rs0 = row_rstd(ssq, u.pm * BM + wr * 64 + lane), rs1 = row_rstd(ssq, u.pm * BM + HALF + wr * 64 + lane);
        asm volatile("" ::: "memory");
#pragma unroll
        for (int ai = 0; ai < 2; ++ai)
#pragma unroll
            for (int m = 0; m < 4; ++m) {
                const int r = u.pm * BM + ai * HALF + wr * 64 + m * 16 + fr; const float rs = __shfl(ai ? rs1 : rs0, m * 16 + fr);
                float hv[8];
#pragma unroll
                for (int n = 0; n < 2; ++n)
#pragma unroll
                    for (int j = 0; j < 4; ++j) { const float gt = acc[ai][0][m][n][j] * rs, up = acc[ai][1][m][n][j] * rs; hv[4 * n + j] = gt * sigm(gt) * up; }
                u32x4 w; w.x = pk2(hv[0], hv[1]); w.y = pk2(hv[2], hv[3]); w.z = pk2(hv[4], hv[5]); w.w = pk2(hv[6], hv[7]);
                if (!dry) st16(H + ((size_t)(u.pm * (DFF / 64) + 2 * u.pn + (wc >> 1)) * 256 + (ai * HALF + wr * 64 + m * 16 + fr)) * 64 + 32 * (wc & 1) + 8 * fq, w);
            }
    }
};
struct EpiResid {
    const float* xin32; float* xout32; bf16_t* xb; float* ssq; float alpha; int row0; int dry; bf16_t* xbo; float* ssqo;
    DI void tail(const f32x4& v0, const f32x4& v1, size_t off, float& sq) const {
        if (!dry) {
            if (xout32) { *(f32x4*)(xout32 + off) = v0; *(f32x4*)(xout32 + off + 4) = v1; }
            else { u32x4 w; w.x = pk2(v0[0], v0[1]); w.y = pk2(v0[2], v0[3]); w.z = pk2(v1[0], v1[1]); w.w = pk2(v1[2], v1[3]); st16(xbo + off, w); }
        }
        sq += (v0[0] * v0[0] + v0[1] * v0[1]) + (v0[2] * v0[2] + v0[3] * v0[3]) + (v1[0] * v1[0] + v1[1] * v1[1]) + (v1[2] * v1[2] + v1[3] * v1[3]);
    }
    DI void operator()(const f32x4 (&acc)[2][2][4][2], const Unit& u, int wr, int wc, int fr, int fq) const {
        if (xin32) {
#pragma unroll
            for (int ai = 0; ai < 2; ++ai) {
                f32x4 v[4][2][2];
#pragma unroll
                for (int m = 0; m < 4; ++m)
#pragma unroll
                    for (int bj = 0; bj < 2; ++bj) { const size_t off = (size_t)(row0 + u.pm * BM + ai * HALF + wr * 64 + m * 16 + fr) * DM + u.pn * BM + wc * 64 + bj * 32 + 8 * fq;
                        v[m][bj][0] = *(const f32x4*)(xin32 + off); v[m][bj][1] = *(const f32x4*)(xin32 + off + 4); }
                asm volatile("" ::: "memory");
#pragma unroll
                for (int m = 0; m < 4; ++m) { const int r = row0 + u.pm * BM + ai * HALF + wr * 64 + m * 16 + fr; float sq = 0.f;
#pragma unroll
                    for (int bj = 0; bj < 2; ++bj) tail(v[m][bj][0] + acc[ai][bj][m][0] * alpha, v[m][bj][1] + acc[ai][bj][m][1] * alpha, (size_t)r * DM + u.pn * BM + wc * 64 + bj * 32 + 8 * fq, sq);
                    sq += __shfl_xor(sq, 16); sq += __shfl_xor(sq, 32);
                    if (fq == 0 && !dry) ssqo[(size_t)r * 16 + u.pn * 4 + wc] = sq; }
                asm volatile("" ::: "memory");
            }
        } else {
            u32x4 x0[4][2], x1[4][2];
#pragma unroll
            for (int m = 0; m < 4; ++m)
#pragma unroll
                for (int bj = 0; bj < 2; ++bj) x0[m][bj] = *(const u32x4*)(xb + (size_t)(row0 + u.pm * BM + wr * 64 + m * 16 + fr) * DM + u.pn * BM + wc * 64 + bj * 32 + 8 * fq);
            asm volatile("" ::: "memory");
#pragma unroll
            for (int m = 0; m < 4; ++m) { const int r = row0 + u.pm * BM + wr * 64 + m * 16 + fr; float sq = 0.f;
#pragma unroll
                for (int bj = 0; bj < 2; ++bj) x1[m][bj] = *(const u32x4*)(xb + (size_t)(r + HALF) * DM + u.pn * BM + wc * 64 + bj * 32 + 8 * fq);
                asm volatile("" ::: "memory");
#pragma unroll
                for (int bj = 0; bj < 2; ++bj) { const u32x4 t = x0[m][bj];
                    tail((f32x4){bflo(t.x), bfhi(t.x), bflo(t.y), bfhi(t.y)} + acc[0][bj][m][0] * alpha, (f32x4){bflo(t.z), bfhi(t.z), bflo(t.w), bfhi(t.w)} + acc[0][bj][m][1] * alpha,
                         (size_t)r * DM + u.pn * BM + wc * 64 + bj * 32 + 8 * fq, sq); }
                sq += __shfl_xor(sq, 16); sq += __shfl_xor(sq, 32);
                if (fq == 0 && !dry) ssqo[(size_t)r * 16 + u.pn * 4 + wc] = sq;
                asm volatile("" ::: "memory"); }
#pragma unroll
            for (int m = 0; m < 4; ++m) { const int r = row0 + u.pm * BM + HALF + wr * 64 + m * 16 + fr; float sq = 0.f;
#pragma unroll
                for (int bj = 0; bj < 2; ++bj) { const u32x4 t = x1[m][bj];
                    tail((f32x4){bflo(t.x), bfhi(t.x), bflo(t.y), bfhi(t.y)} + acc[1][bj][m][0] * alpha, (f32x4){bflo(t.z), bfhi(t.z), bflo(t.w), bfhi(t.w)} + acc[1][bj][m][1] * alpha,
                         (size_t)r * DM + u.pn * BM + wc * 64 + bj * 32 + 8 * fq, sq); }
                sq += __shfl_xor(sq, 16); sq += __shfl_xor(sq, 32);
                if (fq == 0 && !dry) ssqo[(size_t)r * 16 + u.pn * 4 + wc] = sq; }
        }
    }
};
struct EpiInProj {
    bf16_t* cols; unsigned char* G; const float* ssq; const float* cosT; const float* sinT; int row0; int dry;
    DI void operator()(const f32x4 (&acc)[2][2][4][2], const Unit& u, int wr, int wc, int fr, int fq) const {
        const int pn = u.pn, lane = fr + 16 * fq;
        const float rs0 = row_rstd(ssq, row0 + u.pm * BM + wr * 64 + lane), rs1 = row_rstd(ssq, row0 + u.pm * BM + HALF + wr * 64 + lane);
        asm volatile("" ::: "memory");
        if (pn < 2 || pn == 4 || pn == 5) {
            const int zt = pn < 2 ? pn : pn - 2;
#pragma unroll
            for (int ai = 0; ai < 2; ++ai)
#pragma unroll
                for (int m = 0; m < 4; ++m) {
                    const int rl = u.pm * BM + ai * HALF + wr * 64 + m * 16 + fr; const float rs = __shfl(ai ? rs1 : rs0, m * 16 + fr), rs2 = rs * rs;
                    const f32x4 z0 = acc[ai][0][m][0] * acc[ai][1][m][0] * rs2, z1 = acc[ai][0][m][1] * acc[ai][1][m][1] * rs2;
                    u32x4 w; w.x = pk2(z0[0], z0[1]); w.y = pk2(z0[2], z0[3]); w.z = pk2(z1[0], z1[1]); w.w = pk2(z1[2], z1[3]);
                    if (!dry) st16(cols + (size_t)rl * INC + zt * 128 + wc * 32 + 8 * fq, w);
                }
            return;
        }
#pragma unroll
        for (int ai = 0; ai < 2; ++ai)
#pragma unroll
            for (int m = 0; m < 4; ++m) {
                const int rl = u.pm * BM + ai * HALF + wr * 64 + m * 16 + fr; const float rs = __shfl(ai ? rs1 : rs0, m * 16 + fr);
                if (pn >= 20) {
#pragma unroll
                    for (int bj = 0; bj < 2; ++bj) { const f32x4 a0 = acc[ai][bj][m][0] * rs, a1 = acc[ai][bj][m][1] * rs;
                        u32x2 w; w.x = pkq4(sigm(a0[0]), sigm(a0[1]), sigm(a0[2]), sigm(a0[3])); w.y = pkq4(sigm(a1[0]), sigm(a1[1]), sigm(a1[2]), sigm(a1[3]));
                        if (!dry) *(u32x2*)(G + (size_t)rl * GZ + (pn - 20) * BM + wc * 64 + bj * 32 + 8 * fq) = w; }
                } else if (pn >= 6 && pn < 10) {
                    const int pos = (row0 + rl) & (SEQ - 1), hh = wc >> 1, dd0 = 32 * (wc & 1) + 8 * fq;
                    const f32x4 c0 = *(const f32x4*)(cosT + pos * 64 + dd0), c1 = *(const f32x4*)(cosT + pos * 64 + dd0 + 4);
                    const f32x4 s0 = *(const f32x4*)(sinT + pos * 64 + dd0), s1 = *(const f32x4*)(sinT + pos * 64 + dd0 + 4);
                    const f32x4 x10 = acc[ai][0][m][0] * rs, x11 = acc[ai][0][m][1] * rs, x20 = acc[ai][1][m][0] * rs, x21 = acc[ai][1][m][1] * rs;
                    const f32x4 y10 = x10 * c0 - x20 * s0, y11 = x11 * c1 - x21 * s1, y20 = x10 * s0 + x20 * c0, y21 = x11 * s1 + x21 * c1;
                    u32x4 w1, w2; w1.x = pk2(y10[0], y10[1]); w1.y = pk2(y10[2], y10[3]); w1.z = pk2(y11[0], y11[1]); w1.w = pk2(y11[2], y11[3]);
                    w2.x = pk2(y20[0], y20[1]); w2.y = pk2(y20[2], y20[3]); w2.z = pk2(y21[0], y21[1]); w2.w = pk2(y21[2], y21[3]);
                    bf16_t* p = cols + (size_t)rl * INC + pn * BM + hh * 128 + dd0;
                    if (!dry) { st16(p, w1); st16(p + 64, w2); }
                } else {
#pragma unroll
                    for (int bj = 0; bj < 2; ++bj) { const f32x4 a0 = acc[ai][bj][m][0] * rs, a1 = acc[ai][bj][m][1] * rs;
                        u32x4 w; w.x = pk2(a0[0], a0[1]); w.y = pk2(a0[2], a0[3]); w.z = pk2(a1[0], a1[1]); w.w = pk2(a1[2], a1[3]);
                        if (!dry) st16(cols + (size_t)rl * INC + pn * BM + wc * 64 + bj * 32 + 8 * fq, w); }
                }
            }
    }
};
struct EpiBranch {
    const unsigned char* Gt; bf16_t* Mb; int dry;
    DI void operator()(const f32x4 (&acc)[2][2][4][2], const Unit& u, int wr, int wc, int fr, int fq) const {
        const int br = u.pn >> 2, pc = u.pn & 3;
#pragma unroll
        for (int ai = 0; ai < 2; ++ai) {
            u32x2 gv[4][2]; u32x4 mv[4][2];
#pragma unroll
            for (int m = 0; m < 4; ++m)
#pragma unroll
                for (int bj = 0; bj < 2; ++bj) { const int rl = u.pm * BM + ai * HALF + wr * 64 + m * 16 + fr;
                    gv[m][bj] = *(const u32x2*)(Gt + (size_t)rl * GZ + u.pn * BM + wc * 64 + bj * 32 + 8 * fq);
                    if (br) mv[m][bj] = *(const u32x4*)(Mb + (size_t)rl * DM + pc * BM + wc * 64 + bj * 32 + 8 * fq); else mv[m][bj] = (u32x4){0u, 0u, 0u, 0u}; }
            asm volatile("" ::: "memory");
#pragma unroll
            for (int m = 0; m < 4; ++m)
#pragma unroll
                for (int bj = 0; bj < 2; ++bj) {
                    const int rl = u.pm * BM + ai * HALF + wr * 64 + m * 16 + fr; const u32x2 g = gv[m][bj]; const u32x4 mm = mv[m][bj];
                    const f32x4 a0 = acc[ai][bj][m][0], a1 = acc[ai][bj][m][1];
                    u32x4 w; w.x = pk2(bflo(mm.x) + ub(g.x, 0) * a0[0], bfhi(mm.x) + ub(g.x, 1) * a0[1]); w.y = pk2(bflo(mm.y) + ub(g.x, 2) * a0[2], bfhi(mm.y) + ub(g.x, 3) * a0[3]);
                    w.z = pk2(bflo(mm.z) + ub(g.y, 0) * a1[0], bfhi(mm.z) + ub(g.y, 1) * a1[1]); w.w = pk2(bflo(mm.w) + ub(g.y, 2) * a1[2], bfhi(mm.w) + ub(g.y, 3) * a1[3]);
                    if (!dry) st16(Mb + (size_t)rl * DM + pc * BM + wc * 64 + bj * 32 + 8 * fq, w);
                }
            asm volatile("" ::: "memory");
        }
    }
};
}

struct Params { const float* in[17]; float* out; unsigned char* ws; int lo, hi; float invf[64]; };
enum { I_X = 0, I_F1N, I_F1G, I_F1U, I_F1D, I_MN, I_WIN, I_CW, I_RB, I_WB, I_WMG, I_WO, I_F2N, I_F2G, I_F2U, I_F2D, I_FN };

struct WJob { const float* src; int ld, K, N; const float* gain; bf16_t* dst; int Kdst, koff, mode, rowoff; float scale; };
DI WJob get_job(const Params& P, int l, int j) {
    WJob w; unsigned char* wl = P.ws + WS_WT + (size_t)l * WLAYER;
    w.gain = nullptr; w.koff = 0; w.mode = 0; w.rowoff = 0; w.scale = 1.f;
    if (j == 0 || j == 1 || j == 11 || j == 12) {
        const bool second = j >= 11; const bool up = (j == 1 || j == 12);
        w.src = P.in[second ? (up ? I_F2U : I_F2G) : (up ? I_F1U : I_F1G)] + (size_t)l * DM * DFF; w.ld = DFF; w.K = DM; w.N = DFF;
        w.gain = P.in[second ? I_F2N : I_F1N] + l * DM; w.dst = (bf16_t*)(wl + (second ? WO6 : WO1)); w.Kdst = DM; w.mode = 1; w.rowoff = up ? 128 : 0;
    } else if (j == 2 || j == 13) {
        w.src = P.in[j == 2 ? I_F1D : I_F2D] + (size_t)l * DFF * DM; w.ld = DM; w.K = DFF; w.N = DM; w.dst = (bf16_t*)(wl + (j == 2 ? WO2 : WO7)); w.Kdst = DFF;
    } else if (j == 3) {
        w.src = P.in[I_WIN] + (size_t)l * DM * INC; w.ld = INC; w.K = DM; w.N = INC; w.gain = P.in[I_MN] + l * DM; w.dst = (bf16_t*)(wl + WO3); w.Kdst = DM; w.mode = 2;
    } else if (j >= 4 && j <= 6) {
        const int i = j - 4; w.src = P.in[I_WMG] + (size_t)(l * 3 + i) * DM * DM; w.ld = DM; w.K = DM; w.N = DM; w.gain = P.in[I_MN] + l * DM; w.dst = (bf16_t*)(wl + WO3); w.Kdst = DM; w.rowoff = INC + i * DM;
    } else if (j >= 7 && j <= 9) {
        const int i = j - 7; w.src = P.in[I_WB] + (size_t)(l * 3 + i) * 512 * DM; w.ld = DM; w.K = 512; w.N = DM; w.dst = (bf16_t*)(wl + WO4); w.Kdst = 512; w.rowoff = i * DM; w.scale = 1.f / 255.f;
    } else {
        w.src = P.in[I_WO] + (size_t)l * DM * DM; w.ld = DM; w.K = DM; w.N = DM; w.dst = (bf16_t*)(wl + WO5); w.Kdst = DM;
    }
    return w;
}
DI void wt_tile(const WJob& w, int tile, LAS float* scr, int lane) {
    const int nbn = w.N / 32, kb = tile / nbn, nb = tile % nbn, k0 = kb * 64, n0 = nb * 32;
    float scale = w.scale;
    if (w.mode == 2) { if (n0 >= 1536 && n0 < 2048) scale = 0.08838834764831845f; else if (n0 >= 3584 && n0 < 4096) scale = 0.125f * LOG2E; }
    f32x4 v[8];
#pragma unroll
    for (int i = 0; i < 8; ++i) { const int kk = i * 8 + (lane >> 3); v[i] = *(const f32x4*)(w.src + (size_t)(k0 + kk) * w.ld + n0 + 4 * (lane & 7)); }
#pragma unroll
    for (int i = 0; i < 8; ++i) { const int kk = i * 8 + (lane >> 3); const float gsc = scale * (w.gain ? w.gain[k0 + kk] : 1.f); LAS float* d = scr + kk * 33 + 4 * (lane & 7);
        d[0] = v[i].x * gsc; d[1] = v[i].y * gsc; d[2] = v[i].z * gsc; d[3] = v[i].w * gsc; }
    asm volatile("s_waitcnt lgkmcnt(0)" ::: "memory");
#pragma unroll
    for (int q = 0; q < 4; ++q) { const int item = q * 64 + lane, n = item >> 3, kc = item & 7, ng = n0 + n; int row;
      if (w.mode == 1) row = (ng >> 7) * 256 + ((ng & 127) >> 5) * 64 + (w.rowoff ? 32 : 0) + (ng & 31);
      else if (w.mode == 2 && (ng < 512 || (ng >= 1024 && ng < 1536))) {
          const int cc_ = ng >= 1024, n5 = ng & 511, zt = n5 >> 7, w7 = n5 & 127; row = (zt < 2 ? zt : zt + 2) * 256 + 64 * (w7 >> 5) + 32 * cc_ + (w7 & 31); }
      else if (w.mode == 2 && ng >= 1536 && ng < 2560) { const int pnn = ng >> 8, cl = ng & 255, hh = cl >> 7, d = cl & 127; const int bjj = d >> 6, dd = d & 63; row = pnn * 256 + 64 * (2 * hh + (dd >> 5)) + 32 * bjj + (dd & 31); }
      else row = w.rowoff + ng;
      const LAS float* s = scr + (8 * kc) * 33 + n;
      u32x4 o; o.x = pk2(s[0], s[33]); o.y = pk2(s[2 * 33], s[3 * 33]); o.z = pk2(s[4 * 33], s[5 * 33]); o.w = pk2(s[6 * 33], s[7 * 33]);
      *(u32x4*)(w.dst + (size_t)row * w.Kdst + w.koff + k0 + 8 * kc) = o; }
    asm volatile("s_waitcnt lgkmcnt(0)" ::: "memory");
}
DI float wave_sum(float v) {
#pragma unroll
    for (int o = 1; o < 64; o <<= 1) v += __shfl_xor(v, o);
    return v;
}
DI void prologue(const Params& P, LAS unsigned char* lds) {
    const int tid = otid(), lane = tid & 63, wid = tid >> 6, G = gridDim.x;
    LAS float* scr = (LAS float*)lds + wid * (64 * 33);
    for (int l = 0; l < 2; ++l)
        for (int j = 0; j < 14; ++j) { const WJob w = get_job(P, l, j); const int ntile = (w.K / 64) * (w.N / 32);
            for (int t = obid() * 8 + wid; t < ntile; t += G * 8) wt_tile(w, t, scr, lane); }
    if (blockIdx.x == 0) { unsigned* bw = (unsigned*)(P.ws + WS_BAR); for (int i = tid; i < XCD_BAR_WORDS; i += 512) bw[i] = 0u; }
    const float* x = P.in[I_X]; bf16_t* xb = (bf16_t*)(P.ws + WS_XB); float* ssq = (float*)(P.ws + WS_SSQ);
    for (int row0 = (obid() * 8 + wid) * 4; row0 < MTOK; row0 += G * 32) {
        f32x4 v[4][4];
#pragma unroll
        for (int q = 0; q < 4; ++q)
#pragma unroll
            for (int j = 0; j < 4; ++j) v[q][j] = ((const f32x4*)(x + (size_t)(row0 + q) * DM) + lane)[64 * j];
#pragma unroll
        for (int q = 0; q < 4; ++q) { float sq = 0.f; u32x2* o8 = (u32x2*)(xb + (size_t)(row0 + q) * DM) + lane;
#pragma unroll
            for (int j = 0; j < 4; ++j) { const f32x4 t = v[q][j]; sq += (t.x * t.x + t.y * t.y) + (t.z * t.z + t.w * t.w); u32x2 o; o.x = pk2(t.x, t.y); o.y = pk2(t.z, t.w); o8[64 * j] = o; }
            sq = wave_sum(sq);
            if (lane < 16) ssq[(size_t)(row0 + q) * 16 + lane] = lane == 0 ? sq : 0.f; }
    }
    float* cosT = (float*)(P.ws + WS_COS); float* sinT = (float*)(P.ws + WS_SIN);
    for (int idx = obid() * 512 + tid; idx < SEQ * 64; idx += G * 512) {
        const int pos = idx >> 6, i = idx & 63;
        const float ang = (float)pos * P.invf[i];
        const double rev = (double)ang * 0.15915494309189535; const float fr = (float)(rev - floor(rev));
        cosT[idx] = __builtin_amdgcn_cosf(fr); sinT[idx] = __builtin_amdgcn_sinf(fr);
    }
}

DI void conv_phase(const Params& P, int l, int dry = 0) {
    bf16_t* cols = (bf16_t*)(P.ws + WS_COLS); const float* cw = P.in[I_CW] + l * 3 * 512;
    const int gt = obid() * 512 + otid(), stride = gridDim.x * 512;
    for (int it = gt; it < (HROWS / 8) * 64; it += stride) {
        const int cg8 = it & 63, t0 = (it >> 6) * 8, ch = cg8 * 8;
        float w0[8], w1[8], w2[8], z1[8], z2[8];
#pragma unroll
        for (int e = 0; e < 8; ++e) { w0[e] = cw[ch + e]; w1[e] = cw[512 + ch + e]; w2[e] = cw[1024 + ch + e]; z1[e] = 0.f; z2[e] = 0.f; }
        if ((t0 & (SEQ - 1)) != 0) {
            const u32x4 a1 = *(const u32x4*)(cols + (size_t)(t0 - 1) * INC + ch), a2 = *(const u32x4*)(cols + (size_t)(t0 - 2) * INC + ch);
#pragma unroll
            for (int e = 0; e < 4; ++e) { z1[2 * e] = bflo(a1[e]); z1[2 * e + 1] = bfhi(a1[e]); z2[2 * e] = bflo(a2[e]); z2[2 * e + 1] = bfhi(a2[e]); }
        }
        u32x4 zz[8], bb[8];
#pragma unroll
        for (int q = 0; q < 8; ++q) { const bf16_t* rp = cols + (size_t)(t0 + q) * INC + ch; zz[q] = *(const u32x4*)rp; bb[q] = *(const u32x4*)(rp + 512); }
        asm volatile("" ::: "memory");
#pragma unroll
        for (int q = 0; q < 8; ++q) {
            float y[8];
#pragma unroll
            for (int e = 0; e < 4; ++e) {
                const float za = bflo(zz[q][e]), zb = bfhi(zz[q][e]);
                y[2 * e] = bflo(bb[q][e]) * (w0[2 * e] * z2[2 * e] + w1[2 * e] * z1[2 * e] + w2[2 * e] * za);
                y[2 * e + 1] = bfhi(bb[q][e]) * (w0[2 * e + 1] * z2[2 * e + 1] + w1[2 * e + 1] * z1[2 * e + 1] + w2[2 * e + 1] * zb);
                z2[2 * e] = z1[2 * e]; z2[2 * e + 1] = z1[2 * e + 1]; z1[2 * e] = za; z1[2 * e + 1] = zb;
            }
            u32x4 o; o.x = pk2(y[0], y[1]); o.y = pk2(y[2], y[3]); o.z = pk2(y[4], y[5]); o.w = pk2(y[6], y[7]);
            if (!dry) *(u32x4*)(cols + (size_t)(t0 + q) * INC + 512 + ch) = o;
        }
    }
}

constexpr int RS = 136;
DI float ret_lg(int hh) { return log2f(1.0f - exp2f(-5.0f - (float)hh)); }
DI void ret_local_unit(const Params& P, LAS unsigned char* lds, int unit) {
    const int tid = otid(), wid = tid >> 6, lane = tid & 63, r = lane & 31, h = lane >> 5;
    const int bl = unit >> 6, hh = (unit >> 4) & 3, seg = unit & 15, rowbase = bl * SEQ + seg * 512;
    const bf16_t* cols = (const bf16_t*)(P.ws + WS_COLS); float* T = (float*)(P.ws + WS_T) + (size_t)unit * 16384;
    LAS bf16_t* Ks = (LAS bf16_t*)lds; LAS bf16_t* Vs = Ks + 64 * RS;
    const float lg = ret_lg(hh);
    const int a = wid >> 1, b0 = (wid & 1) * 2, tg = (lane >> 4) & 1, tq = (lane & 15) >> 2, tp = lane & 3;
    f32x16 acc[2];
#pragma unroll
    for (int i = 0; i < 16; ++i) { acc[0][i] = 0.f; acc[1][i] = 0.f; }
    u32x4 pk[2], pv[2];
#pragma unroll
    for (int e = 0; e < 2; ++e) { const int idx = tid + 512 * e, row = idx >> 4, sg = idx & 15; const bf16_t* gp = cols + (size_t)(rowbase + row) * INC + hh * 128 + sg * 8;
        pk[e] = *(const u32x4*)(gp + 2048); pv[e] = *(const u32x4*)(gp + 2560); }
    for (int c = 0; c < 8; ++c) {
        __syncthreads();
#pragma unroll
        for (int e = 0; e < 2; ++e) { const int idx = tid + 512 * e, row = idx >> 4, sg = idx & 15;
            const u32x4 kv = pk[e], vv = pv[e];
            if (c + 1 < 8) { const bf16_t* gp = cols + (size_t)(rowbase + (c + 1) * 64 + row) * INC + hh * 128 + sg * 8; pk[e] = *(const u32x4*)(gp + 2048); pv[e] = *(const u32x4*)(gp + 2560); }
            const float sc = exp2f(lg * (float)(511 - (c * 64 + row)));
            u32x4 ks; ks.x = pk2(bflo(kv.x) * sc, bfhi(kv.x) * sc); ks.y = pk2(bflo(kv.y) * sc, bfhi(kv.y) * sc); ks.z = pk2(bflo(kv.z) * sc, bfhi(kv.z) * sc); ks.w = pk2(bflo(kv.w) * sc, bfhi(kv.w) * sc);
            *(LAS u32x4*)(Ks + row * RS + sg * 8) = ks; *(LAS u32x4*)(Vs + row * RS + sg * 8) = vv; }
        __syncthreads();
#pragma unroll
        for (int s = 0; s < 4; ++s) {
            const int tr0 = (16 * s + 8 * h + tq) * RS + 16 * tg + 4 * tp;
            const bf16x8 af = cat8(trd(Ks + tr0 + 32 * a), trd(Ks + tr0 + 4 * RS + 32 * a));
            const bf16x8 bf0 = cat8(trd(Vs + tr0 + 32 * b0), trd(Vs + tr0 + 4 * RS + 32 * b0)), bf1 = cat8(trd(Vs + tr0 + 32 * (b0 + 1)), trd(Vs + tr0 + 4 * RS + 32 * (b0 + 1)));
            acc[0] = MFMA32(af, bf0, acc[0]); acc[1] = MFMA32(af, bf1, acc[1]);
        }
    }
#pragma unroll
    for (int bb = 0; bb < 2; ++bb)
#pragma unroll
        for (int i = 0; i < 16; ++i) T[(size_t)(32 * a + crow(i, h)) * 128 + 32 * (b0 + bb) + r] = acc[bb][i];
}
DI void ret_scan_unit(const Params& P, LAS unsigned char* lds, int unit, int dry = 0) {
    const int tid = otid(), wid = tid >> 6, lane = tid & 63, r = lane & 31, h = lane >> 5;
    const int bl = unit >> 6, hh = (unit >> 4) & 3, seg = unit & 15, rowbase = bl * SEQ + seg * 512;
    bf16_t* cols = (bf16_t*)(P.ws + WS_COLS); const float* T = (const float*)(P.ws + WS_T);
    LAS bf16_t* Qs = (LAS bf16_t*)lds; LAS bf16_t* Ks = Qs + 64 * RS; LAS bf16_t* Kd = Ks + 64 * RS; LAS bf16_t* Vs = Kd + 64 * RS; LAS bf16_t* St = Vs + 64 * RS;
    LAS float* red = (LAS float*)(St + 128 * RS);
    const float lg = ret_lg(hh);
    const int a = wid >> 1, b0 = (wid & 1) * 2, nt = wid >> 2, vt = wid & 3, tg = (lane >> 4) & 1, tq = (lane & 15) >> 2, tp = lane & 3;
    f32x16 Sacc[2];
#pragma unroll
    for (int i = 0; i < 16; ++i) { Sacc[0][i] = 0.f; Sacc[1][i] = 0.f; }
    for (int p = 0; p < seg; ++p) {
        const float f = exp2f(lg * 512.0f * (float)(seg - 1 - p)); const float* Tp = T + (size_t)(unit - seg + p) * 16384;
#pragma unroll
        for (int bb = 0; bb < 2; ++bb)
#pragma unroll
            for (int i = 0; i < 16; ++i) Sacc[bb][i] += f * Tp[(size_t)(32 * a + crow(i, h)) * 128 + 32 * (b0 + bb) + r];
    }
    const float g64 = exp2f(lg * 64.0f);
    u32x4 pq[2], pk[2], pv[2];
#pragma unroll
    for (int e = 0; e < 2; ++e) { const int idx = tid + 512 * e, row = idx >> 4, sg = idx & 15; const bf16_t* gp = cols + (size_t)(rowbase + row) * INC + hh * 128 + sg * 8;
        pq[e] = *(const u32x4*)(gp + 1536); pk[e] = *(const u32x4*)(gp + 2048); pv[e] = *(const u32x4*)(gp + 2560); }
    __syncthreads();
    for (int c = 0; c < 8; ++c) {
#pragma unroll
        for (int bb = 0; bb < 2; ++bb)
#pragma unroll
            for (int g4 = 0; g4 < 4; ++g4) { u32x2 w; w.x = pk2(Sacc[bb][4 * g4], Sacc[bb][4 * g4 + 1]); w.y = pk2(Sacc[bb][4 * g4 + 2], Sacc[bb][4 * g4 + 3]);
                *(LAS u32x2*)(St + (32 * (b0 + bb) + r) * RS + 32 * a + 8 * g4 + 4 * h) = w; }
#pragma unroll
        for (int e = 0; e < 2; ++e) { const int idx = tid + 512 * e, row = idx >> 4, sg = idx & 15;
            const u32x4 qv = pq[e], kv = pk[e], vv = pv[e];
            const float sc = ex2(lg * (float)(63 - row));
            u32x4 ks; ks.x = pk2(bflo(kv.x) * sc, bfhi(kv.x) * sc); ks.y = pk2(bflo(kv.y) * sc, bfhi(kv.y) * sc); ks.z = pk2(bflo(kv.z) * sc, bfhi(kv.z) * sc); ks.w = pk2(bflo(kv.w) * sc, bfhi(kv.w) * sc);
            *(LAS u32x4*)(Qs + row * RS + sg * 8) = qv; *(LAS u32x4*)(Ks + row * RS + sg * 8) = kv; *(LAS u32x4*)(Kd + row * RS + sg * 8) = ks; *(LAS u32x4*)(Vs + row * RS + sg * 8) = vv; }
        __syncthreads();
        if (c + 1 < 8) {
#pragma unroll
            for (int e = 0; e < 2; ++e) { const int idx = tid + 512 * e, row = idx >> 4, sg = idx & 15; const bf16_t* gp = cols + (size_t)(rowbase + (c + 1) * 64 + row) * INC + hh * 128 + sg * 8;
                pq[e] = *(const u32x4*)(gp + 1536); pk[e] = *(const u32x4*)(gp + 2048); pv[e] = *(const u32x4*)(gp + 2560); }
        }
        f32x16 pT[2];
#pragma unroll
        for (int i = 0; i < 16; ++i) { pT[0][i] = 0.f; pT[1][i] = 0.f; }
#pragma unroll
        for (int ks = 0; ks < 8; ++ks) {
            const bf16x8 qf = *(const LAS bf16x8*)(Qs + (32 * nt + r) * RS + 16 * ks + 8 * h);
            const bf16x8 k0 = *(const LAS bf16x8*)(Ks + r * RS + 16 * ks + 8 * h), k1 = *(const LAS bf16x8*)(Ks + (32 + r) * RS + 16 * ks + 8 * h);
            pT[0] = MFMA32(k0, qf, pT[0]); pT[1] = MFMA32(k1, qf, pT[1]);
        }
        const int nq = 32 * nt + r;
#pragma unroll
        for (int mt = 0; mt < 2; ++mt)
#pragma unroll
            for (int i = 0; i < 16; ++i) { const int mm = 32 * mt + crow(i, h); const int dd = nq > mm ? nq - mm : mm - nq; pT[mt][i] *= ex2(lg * (float)dd); }
        f32x16 O1, O2;
#pragma unroll
        for (int i = 0; i < 16; ++i) { O1[i] = 0.f; O2[i] = 0.f; }
#pragma unroll
        for (int mt = 0; mt < 2; ++mt)
#pragma unroll
            for (int s = 0; s < 2; ++s) {
                const bf16x8 af = pack8(pT[mt][8 * s], pT[mt][8 * s + 1], pT[mt][8 * s + 2], pT[mt][8 * s + 3], pT[mt][8 * s + 4], pT[mt][8 * s + 5], pT[mt][8 * s + 6], pT[mt][8 * s + 7]);
                const int tr0 = (32 * mt + 16 * s + 4 * h + tq) * RS + 32 * vt + 16 * tg + 4 * tp;
                const bf16x8 bf = cat8(trd(Vs + tr0), trd(Vs + tr0 + 8 * RS));
                O1 = MFMA32(af, bf, O1);
            }
#pragma unroll
        for (int ks = 0; ks < 8; ++ks) {
            const bf16x8 qf = *(const LAS bf16x8*)(Qs + (32 * nt + r) * RS + 16 * ks + 8 * h);
            const bf16x8 sf = *(const LAS bf16x8*)(St + (32 * vt + r) * RS + 16 * ks + 8 * h);
            O2 = MFMA32(qf, sf, O2);
        }
#pragma unroll
        for (int i = 0; i < 16; ++i) { const int n = 32 * nt + crow(i, h); O1[i] += ex2(lg * (float)(n + 1)) * O2[i]; }
#pragma unroll
        for (int i = 0; i < 16; ++i) { float v = O1[i] * O1[i];
            v += __builtin_bit_cast(float, __builtin_amdgcn_update_dpp(0, __builtin_bit_cast(int, v), 0xB1, 0xf, 0xf, false));
            v += __builtin_bit_cast(float, __builtin_amdgcn_update_dpp(0, __builtin_bit_cast(int, v), 0x4E, 0xf, 0xf, false));
            v += __builtin_bit_cast(float, __builtin_amdgcn_update_dpp(0, __builtin_bit_cast(int, v), 0x141, 0xf, 0xf, false));
            v += __builtin_bit_cast(float, __builtin_amdgcn_update_dpp(0, __builtin_bit_cast(int, v), 0x140, 0xf, 0xf, false));
            v += __shfl_xor(v, 16);
            if (r == 0) red[(32 * nt + crow(i, h)) * 4 + vt] = v; }
        bf16_t gq[16];
#pragma unroll
        for (int i = 0; i < 16; ++i) gq[i] = cols[(size_t)(rowbase + c * 64 + 32 * nt + crow(i, h)) * INC + 3072 + hh * 128 + 32 * vt + r];
#pragma unroll
        for (int i = 0; i < 16; ++i) { Sacc[0][i] *= g64; Sacc[1][i] *= g64; }
#pragma unroll
        for (int s = 0; s < 4; ++s) {
            const int tr0 = (16 * s + 8 * h + tq) * RS + 16 * tg + 4 * tp;
            const bf16x8 af = cat8(trd(Kd + tr0 + 32 * a), trd(Kd + tr0 + 4 * RS + 32 * a));
            const bf16x8 bf0 = cat8(trd(Vs + tr0 + 32 * b0), trd(Vs + tr0 + 4 * RS + 32 * b0)), bf1 = cat8(trd(Vs + tr0 + 32 * (b0 + 1)), trd(Vs + tr0 + 4 * RS + 32 * (b0 + 1)));
            Sacc[0] = MFMA32(af, bf0, Sacc[0]); Sacc[1] = MFMA32(af, bf1, Sacc[1]);
        }
        __syncthreads();
#pragma unroll
        for (int i = 0; i < 16; ++i) { const int n = 32 * nt + crow(i, h); const f32x4 q = *(const LAS f32x4*)(red + n * 4);
            const float rn = __builtin_amdgcn_rsqf(((q.x + q.y) + (q.z + q.w)) * (1.f / 128.f) + EPS);
            bf16_t* gp = cols + (size_t)(rowbase + c * 64 + n) * INC + 3072 + hh * 128 + 32 * vt + r;
            const float gv = bf2f(gq[i]); const bf16_t yv = f2bf(gv * sigm(gv) * O1[i] * rn); if (!dry) *gp = yv; }
    }
}

constexpr int ATT_BIAS_OFF = 0, ATT_SCR_OFF = 8704, ATT_T_OFF = 10240, ATT_WAVE_BYTES = 16384;
DI void att_dma_tile(const bf16_t* gsrc, LAS unsigned char* tile, int lane) {
#pragma unroll
    for (int e = 0; e < 8; ++e) { const int row = e * 8 + (lane >> 3), pos = lane & 7;
        __builtin_amdgcn_global_load_lds((const unsigned*)(gsrc + (size_t)row * INC + ((pos ^ (row & 7)) << 3)), (LAS unsigned*)(tile + e * 1024), 16, 0, 0); }
}
DI void attn_unit(bf16_t* cols, LAS unsigned char* lds, int wid, int lane, int bl, int hh, int c, int dry) {
    const int r = lane & 31, h = lane >> 5, tg = (lane >> 4) & 1, tq = (lane & 15) >> 2, tp = lane & 3;
    const LAS float* bt = (const LAS float*)(lds + ATT_BIAS_OFF) + hh * 264;
    LAS float* scr = (LAS float*)(lds + ATT_SCR_OFF) + wid * 32;
    LAS unsigned char* Kt = lds + ATT_T_OFF + wid * ATT_WAVE_BYTES; LAS unsigned char* Vt = Kt + 8192;
    const int seqbase = bl * SEQ, tq0 = seqbase + c * 64;
    const int j0 = c >= 8 ? 0 : 8 - c;
    { const bf16_t* kb = cols + (size_t)(seqbase + (c - 8 + j0) * 64) * INC + 4096 + hh * 64; att_dma_tile(kb, Kt, lane); att_dma_tile(kb + 512, Vt, lane); }
    bf16x8 qf[2][4];
#pragma unroll
    for (int qt = 0; qt < 2; ++qt)
#pragma unroll
        for (int d0 = 0; d0 < 4; ++d0) qf[qt][d0] = *(const bf16x8*)(cols + (size_t)(tq0 + 32 * qt + r) * INC + 3584 + hh * 64 + 16 * d0 + 8 * h);
    float mrow[2] = {-1e30f, -1e30f}, lsum[2] = {0.f, 0.f};
    f32x16 O[2][2];
#pragma unroll
    for (int i = 0; i < 16; ++i) { O[0][0][i] = 0.f; O[0][1][i] = 0.f; O[1][0][i] = 0.f; O[1][1][i] = 0.f; }
    for (int j = j0; j <= 8; ++j) {
        const bf16_t* kbn = cols + (size_t)(seqbase + (c - 7 + j) * 64) * INC + 4096 + hh * 64;
        asm volatile("s_waitcnt vmcnt(8)" ::: "memory");
        bf16x8 kf[2][4];
#pragma unroll
        for (int t = 0; t < 2; ++t)
#pragma unroll
            for (int d0 = 0; d0 < 4; ++d0) { const int row = 32 * t + r, ch = 2 * d0 + h; kf[t][d0] = *(const LAS bf16x8*)(Kt + row * 128 + ((ch ^ (row & 7)) << 4)); }
        asm volatile("s_waitcnt lgkmcnt(0)" ::: "memory");
        if (j < 8) att_dma_tile(kbn, Kt, lane);
        asm volatile("" ::: "memory");
        bf16x8 pf[2][4];
#pragma unroll
        for (int qt = 0; qt < 2; ++qt) {
            const int n = 32 * qt + r;
            f32x16 sT[2];
            { const float b = j <= 5 ? bt[256] : 0.f;
#pragma unroll
              for (int i = 0; i < 16; ++i) { sT[0][i] = b; sT[1][i] = b; } }
#pragma unroll
            for (int d0 = 0; d0 < 4; ++d0) { sT[0] = MFMA32(kf[0][d0], qf[qt][d0], sT[0]); sT[1] = MFMA32(kf[1][d0], qf[qt][d0], sT[1]); }
            if (j > 5) {
#pragma unroll
                for (int t = 0; t < 2; ++t)
#pragma unroll
                    for (int i = 0; i < 16; ++i) { const int mm = 32 * t + crow(i, h); int dist = 64 * (8 - j) + n - mm; dist = dist > 128 ? 128 : dist; sT[t][i] += bt[dist + 128]; }
            }
            float mx = fmaxf(sT[0][0], sT[1][0]);
#pragma unroll
            for (int i = 1; i < 16; ++i) mx = fmaxf(mx, fmaxf(sT[0][i], sT[1][i]));
            mx = fmaxf(mx, __shfl_xor(mx, 32));
            if (__any(mx > mrow[qt])) {
                const float mnew = fmaxf(mrow[qt], mx), alpha = ex2(mrow[qt] - mnew); mrow[qt] = mnew; lsum[qt] *= alpha;
                if (h == 0) scr[r] = alpha;
                asm volatile("s_waitcnt lgkmcnt(0)" ::: "memory");
#pragma unroll
                for (int g4 = 0; g4 < 4; ++g4) { const f32x4 a4 = *(const LAS f32x4*)(scr + 8 * g4 + 4 * h);
#pragma unroll
                    for (int e = 0; e < 4; ++e) { O[qt][0][4 * g4 + e] *= a4[e]; O[qt][1][4 * g4 + e] *= a4[e]; } }
                asm volatile("s_waitcnt lgkmcnt(0)" ::: "memory");
            }
            float ls = 0.f;
#pragma unroll
            for (int t = 0; t < 2; ++t)
#pragma unroll
                for (int i = 0; i < 16; ++i) { const float p = ex2(sT[t][i] - mrow[qt]); sT[t][i] = p; ls += p; }
            lsum[qt] += ls;
#pragma unroll
            for (int t = 0; t < 2; ++t)
#pragma unroll
                for (int s2 = 0; s2 < 2; ++s2)
                    pf[qt][2 * t + s2] = pack8(sT[t][8 * s2], sT[t][8 * s2 + 1], sT[t][8 * s2 + 2], sT[t][8 * s2 + 3], sT[t][8 * s2 + 4], sT[t][8 * s2 + 5], sT[t][8 * s2 + 6], sT[t][8 * s2 + 7]);
        }
        if (j < 8) asm volatile("s_waitcnt vmcnt(8)" ::: "memory"); else asm volatile("s_waitcnt vmcnt(0)" ::: "memory");
#pragma unroll
        for (int t = 0; t < 2; ++t)
#pragma unroll
            for (int s2 = 0; s2 < 2; ++s2) {
                const int row = 32 * t + 16 * s2 + 4 * h + tq;
#pragma unroll
                for (int dh = 0; dh < 2; ++dh) {
                    const int ch = 4 * dh + 2 * tg + (tp >> 1), off = (((ch ^ (row & 7)) << 4) + ((tp & 1) << 3));
                    const bf16x8 bf = cat8(trd((const LAS bf16_t*)(Vt + row * 128 + off)), trd((const LAS bf16_t*)(Vt + (row + 8) * 128 + off)));
                    O[0][dh] = MFMA32(pf[0][2 * t + s2], bf, O[0][dh]); O[1][dh] = MFMA32(pf[1][2 * t + s2], bf, O[1][dh]);
                }
            }
        asm volatile("s_waitcnt lgkmcnt(0)" ::: "memory");
        if (j < 8) att_dma_tile(kbn + 512, Vt, lane);
        asm volatile("" ::: "memory");
    }
#pragma unroll
    for (int qt = 0; qt < 2; ++qt) {
        float l = lsum[qt]; l += __shfl_xor(l, 32);
        if (h == 0) scr[r] = l;
        asm volatile("s_waitcnt lgkmcnt(0)" ::: "memory");
#pragma unroll
        for (int i = 0; i < 16; ++i) { const int q = crow(i, h); const float inv = __builtin_amdgcn_rcpf(scr[q]);
            bf16_t* op = cols + (size_t)(tq0 + 32 * qt + q) * INC + 3584 + hh * 64 + r;
            const bf16_t o0 = f2bf(O[qt][0][i] * inv), o1 = f2bf(O[qt][1][i] * inv); if (!dry) { op[0] = o0; op[32] = o1; } }
        asm volatile("s_waitcnt lgkmcnt(0)" ::: "memory");
    }
    asm volatile("s_waitcnt vmcnt(0)" ::: "memory");
}
DI void attn_phase(const Params& P, LAS unsigned char* lds, int l, int dry = 0) {
    const int tid = otid(), lane = tid & 63, wid = __builtin_amdgcn_readfirstlane(tid >> 6);
    LAS float* bias = (LAS float*)(lds + ATT_BIAS_OFF); const float* rb = P.in[I_RB] + l * 8 * 257;
    __syncthreads();
    for (int i = tid; i < 8 * 257; i += 512) bias[(i / 257) * 264 + (i % 257)] = rb[i] * LOG2E;
    __syncthreads();
    bf16_t* cols = (bf16_t*)(P.ws + WS_COLS);
    for (int u = obid() * 8 + wid; u < 4096; u += gridDim.x * 8) {
        const int c = u & 127, hh = (u >> 7) & 7, bl = u >> 10;
        attn_unit(cols, lds, wid, lane, bl, hh, c, dry);
    }
    asm volatile("s_waitcnt vmcnt(0)" ::: "memory");
    __syncthreads();
}

DI void final_norm(const Params& P, int dry = 0) {
    const int tid = otid(), lane = tid & 63, wid = tid >> 6; const float* ssq = (const float*)(P.ws + WS_SSQ); const float* w = P.in[I_FN]; const bf16_t* xb = (const bf16_t*)(P.ws + WS_XB);
    for (int row0 = (obid() * 8 + wid) * 4; row0 < MTOK; row0 += gridDim.x * 32) {
        u32x4 xv[4][2]; float rs[4];
#pragma unroll
        for (int q = 0; q < 4; ++q) { rs[q] = row_rstd(ssq, row0 + q);
#pragma unroll
            for (int j = 0; j < 2; ++j) xv[q][j] = *(const u32x4*)(xb + (size_t)(row0 + q) * DM + 512 * j + 8 * lane); }
#pragma unroll
        for (int q = 0; q < 4; ++q)
#pragma unroll
            for (int j = 0; j < 2; ++j) {
                const int c0 = 512 * j + 8 * lane; const u32x4 t = xv[q][j];
                const f32x4 g0 = *(const f32x4*)(w + c0), g1 = *(const f32x4*)(w + c0 + 4);
                const f32x4 o0 = (f32x4){bflo(t.x), bfhi(t.x), bflo(t.y), bfhi(t.y)} * rs[q] * g0, o1 = (f32x4){bflo(t.z), bfhi(t.z), bflo(t.w), bfhi(t.w)} * rs[q] * g1;
                if (!dry) { *(f32x4*)(P.out + (size_t)(row0 + q) * DM + c0) = o0; *(f32x4*)(P.out + (size_t)(row0 + q) * DM + c0 + 4) = o1; }
            }
    }
}

#define XB_TMO      128
#define XB_XCNT(j)  (256  + 64 * (j))
#define XB_XSUB(j)  (1280 + 64 * (j))
#define XB_XGEN(j)  (2304 + 64 * (j))
#define XB_TOP      3328
#define XB_TOPGEN   3392
#define XB_SPIN_CAP (1u << 22)
DI unsigned xb_ld(unsigned* p)              { return __hip_atomic_load(p, __ATOMIC_RELAXED, __HIP_MEMORY_SCOPE_AGENT); }
DI unsigned xb_add(unsigned* p, unsigned v) { return __hip_atomic_fetch_add(p, v, __ATOMIC_RELAXED, __HIP_MEMORY_SCOPE_AGENT); }
DI unsigned xb_xcc_id() { return (unsigned)__builtin_amdgcn_s_getreg((3 << 11) | 20) & 0xFu; }
#define XB_SPIN(cond, bar) do { unsigned _sp = 0; while (cond) { __builtin_amdgcn_s_sleep(1); \
    if ((++_sp & 255u) == 0u) { if (xb_ld(&(bar)[XB_TMO])) break; if (_sp > XB_SPIN_CAP) { atomicAdd(&(bar)[XB_TMO], 1u); break; } } } } while (0)
struct XcdBarrier { unsigned* bar; unsigned x; volatile LAS unsigned* st; };
DI XcdBarrier xcd_barrier_post(unsigned* bar, volatile LAS unsigned* st) {
    XcdBarrier b; b.bar = bar; b.x = xb_xcc_id(); b.st = st;
    if (threadIdx.x == 0) (void)xb_add(&bar[XB_XCNT(b.x)], 1u);
    return b;
}
DI void xcd_barrier_complete(unsigned* bar, unsigned x, unsigned& nloc, unsigned& nx) {
    const unsigned G = gridDim.x * gridDim.y * gridDim.z;
    unsigned sum, cnt, mine, sp = 0u;
    for (;;) {
        sum = 0u; cnt = 0u; mine = 0u;
#pragma unroll
        for (unsigned j = 0; j < 16; ++j) { const unsigned c = xb_ld(&bar[XB_XCNT(j)]); sum += c; cnt += (c > 0u) ? 1u : 0u; mine = (j == x) ? c : mine; }
        if (sum == G) break;
        __builtin_amdgcn_s_sleep(1);
        if ((++sp & 255u) == 0u) { if (xb_ld(&bar[XB_TMO])) break; if (sp > XB_SPIN_CAP) { atomicAdd(&bar[XB_TMO], 1u); break; } }
    }
    nloc = mine > 0u ? mine : 1u; nx = cnt > 0u ? cnt : 1u;
}
DI void xcd_barrier(const XcdBarrier& b) {
    asm volatile("s_waitcnt vmcnt(0)" ::: "memory");
    __syncthreads();
    if (threadIdx.x == 0) {
        unsigned* bar = b.bar;
        __builtin_amdgcn_s_waitcnt(0);
        unsigned nloc = b.st[0], nx = b.st[1];
        if (nloc == 0u) { xcd_barrier_complete(bar, b.x, nloc, nx); b.st[0] = nloc; b.st[1] = nx; }
        const unsigned old = xb_add(&bar[XB_XSUB(b.x)], 1u);
        const unsigned gen = old / nloc;
        if (old + 1u == (gen + 1u) * nloc) {
            __builtin_amdgcn_fence(__ATOMIC_RELEASE, "agent");
            asm volatile("s_waitcnt vmcnt(0)" ::: "memory");
            const unsigned og = xb_add(&bar[XB_TOP], 1u);
            const unsigned tg = og / nx;
            if (og + 1u == (tg + 1u) * nx) xb_add(&bar[XB_TOPGEN], 1u);
            else XB_SPIN(xb_ld(&bar[XB_TOPGEN]) == tg, bar);
            __builtin_amdgcn_fence(__ATOMIC_ACQUIRE, "agent");
            xb_add(&bar[XB_XGEN(b.x)], 1u);
            asm volatile("s_waitcnt vmcnt(0)" ::: "memory");
        } else {
            XB_SPIN(xb_ld(&bar[XB_XGEN(b.x)]) == gen, bar);
            __builtin_amdgcn_fence(__ATOMIC_ACQUIRE, "agent");
            asm volatile("s_waitcnt vmcnt(0)" ::: "memory");
        }
    }
    __syncthreads();
}

constexpr int NPHASE = 30;
__global__ void __launch_bounds__(512, 2) fwd_kernel(Params Parg) {
    extern __shared__ __attribute__((aligned(16))) unsigned char lds_raw[];
    LAS unsigned char* lds = (LAS unsigned char*)lds_raw;
    const int G = gridDim.x;
    typedef const __attribute__((address_space(4))) Params* KP;
    const KP Pk = (KP)__builtin_amdgcn_kernarg_segment_ptr();
    const int ph_lo = Pk->lo, ph_hi = Pk->hi;
#define XB ((bf16_t*)(ws + WS_XB))
#define COLS ((bf16_t*)(ws + WS_COLS))
#define GB ((bf16_t*)(ws + WS_G))
#define HID ((bf16_t*)(ws + WS_HID))
#define SSQ ((float*)(ws + WS_SSQ))
    volatile LAS unsigned* MISC = (volatile LAS unsigned*)(lds + LDS_BYTES - 64);
    if (threadIdx.x < 4) MISC[threadIdx.x] = 0u;
    __syncthreads();
    XcdBarrier bar; bar.bar = (unsigned*)(Pk->ws + WS_BAR); bar.x = 0; bar.st = MISC;
    for (int ph = ph_lo; ph < ph_hi; ++ph) {
        if (ph >= 1 && ph < NPHASE - 1 && ((ph - 1) % 14) == 7) continue;
        if (ph > ph_lo) {
            if (ph == ph_lo + 1) { cg::this_grid().sync(); bar = xcd_barrier_post((unsigned*)(Pk->ws + WS_BAR), MISC); }
            else xcd_barrier(bar);
        }
        KP Pp = Pk; asm volatile("" : "+s"(Pp));
        const Params& P = *(const Params*)Pp;
        unsigned char* ws = P.ws;
        if (ph == 0) { prologue(P, lds); if (PROBE == 3) prologue(P, lds); continue; }
        if (ph == NPHASE - 1) { if (PROBE == 3) final_norm(P, P.hi != 12345); final_norm(P); continue; }
        const int l = (ph - 1) / 14, k = (ph - 1) % 14;
        unsigned char* wl = ws + WS_WT + (size_t)l * WLAYER;
        pg8::StaticOrder S;
        if (k == 0 || k == 12) {
            pg8::Gemm g{XB, (const bf16_t*)(wl + (k == 0 ? WO1 : WO6)), DM, DM, 128, 256 * DM * 2}; S.init(MTOK, 2 * DFF, G, obid());
            pg8::EpiGateUp E{HID, SSQ, 0};
#if PROBE == 11
            { pg8::EpiGateUp Ed = E; Ed.dry = (P.hi != 12345); pg8::gemm_phase<pg8::EpiGateUp>(lds, g, S, Ed); }
#endif
            for (int rep = 0; rep < (PROBE == 2 ? 2 : 1); ++rep) pg8::gemm_phase<pg8::EpiGateUp>(lds, g, S, E, STAGGER);
        } else if (k == 1 || k == 13) {
            pg8::Gemm g{HID, (const bf16_t*)(wl + (k == 1 ? WO2 : WO7)), DFF, 64, 32768, (DFF / 64) * 32768}; S.init(MTOK, DM, G, obid());
            pg8::EpiResid E{(l == 0 && k == 1) ? P.in[I_X] : (const float*)nullptr, (float*)nullptr, XB, SSQ, 0.5f, 0, 0, XB, SSQ};
#if PROBE == 9
            { pg8::EpiResid Ed = E; Ed.xout32 = nullptr; Ed.xbo = (bf16_t*)(ws + (P.hi != 12345 ? 848 * MiB : WS_XB)); Ed.ssqo = (float*)(ws + (P.hi != 12345 ? 980 * MiB : WS_SSQ)); pg8::gemm_phase<pg8::EpiResid>(lds, g, S, Ed); }
#endif
#if PROBE == 4 || PROBE == 10
            { pg8::EpiResid Ed = E; Ed.dry = (P.hi != 12345); pg8::gemm_phase<pg8::EpiResid>(lds, g, S, Ed); }
#endif
            pg8::gemm_phase<pg8::EpiResid>(lds, g, S, E);
        } else {
            const int half = (k - 2) / 5, kk = (k - 2) % 5, row0 = half * HROWS;
            if (kk == 0) {
                pg8::Gemm g{XB + (size_t)row0 * DM, (const bf16_t*)(wl + WO3), DM, DM, 128, 256 * DM * 2}; S.init(HROWS, NCAT, G, obid());
                pg8::EpiInProj E{COLS, (unsigned char*)GB, SSQ, (const float*)(ws + WS_COS), (const float*)(ws + WS_SIN), row0, 0};
#if PROBE == 11
                { pg8::EpiInProj Ed = E; Ed.dry = (P.hi != 12345); pg8::gemm_phase<pg8::EpiInProj>(lds, g, S, Ed); }
#endif
                for (int rep = 0; rep < (PROBE == 2 ? 2 : 1); ++rep) pg8::gemm_phase<pg8::EpiInProj>(lds, g, S, E, STAGGER);
            } else if (kk == 1) {
#if PROBE == 1
                if (P.hi != 12345) { for (int u = obid(); u < 256; u += G) ret_local_unit(P, lds, u); conv_phase(P, l, P.hi != 12345); }
#endif
                if (HAS(4)) { for (int u = obid(); u < 256; u += G) ret_local_unit(P, lds, u);
                conv_phase(P, l); }
            } else if (kk == 2) {
#if PROBE == 1
                if (P.hi != 12345) { for (int u = obid(); u < 256; u += G) ret_scan_unit(P, lds, u, P.hi != 12345); attn_phase(P, lds, l, P.hi != 12345); }
#endif
                if (HAS(5)) for (int u = obid(); u < 256; u += G) ret_scan_unit(P, lds, u);
                if (HAS(6)) attn_phase(P, lds, l);
            } else if (kk == 3) {
                pg8::Gemm g{COLS, (const bf16_t*)(wl + WO4), 512, INC, 128, 256 * INC * 2}; S.init(HROWS, DM, G, obid(), 1);
                pg8::EpiBranch E{(const unsigned char*)GB, (bf16_t*)(ws + WS_MB), 0};
#if PROBE == 12
                { pg8::EpiBranch Ed = E; Ed.dry = (P.hi != 12345); pg8::gemm_phase<pg8::EpiBranch, true>(lds, g, S, Ed); }
#endif
                pg8::gemm_phase<pg8::EpiBranch, true>(lds, g, S, E);
            } else {
                pg8::Gemm g{(const bf16_t*)(ws + WS_MB), (const bf16_t*)(wl + WO5), DM, DM, 128, 256 * DM * 2}; S.init(HROWS, DM, G, obid());
                pg8::EpiResid E{nullptr, nullptr, XB, SSQ, 1.0f, row0, 0, XB, SSQ};
#if PROBE == 9
                { pg8::EpiResid Ed = E; Ed.xbo = (bf16_t*)(ws + (P.hi != 12345 ? 848 * MiB : WS_XB)); Ed.ssqo = (float*)(ws + (P.hi != 12345 ? 980 * MiB : WS_SSQ)); pg8::gemm_phase<pg8::EpiResid>(lds, g, S, Ed); }
#endif
#if PROBE == 4 || PROBE == 10
                { pg8::EpiResid Ed = E; Ed.dry = (P.hi != 12345); pg8::gemm_phase<pg8::EpiResid>(lds, g, S, Ed); }
#endif
                pg8::gemm_phase<pg8::EpiResid>(lds, g, S, E);
                if (half == 0) {
                    pg8::Gemm g3{XB + (size_t)HROWS * DM, (const bf16_t*)(wl + WO3), DM, DM, 128, 256 * DM * 2}; pg8::StaticOrder S3; S3.init(HROWS, NCAT, G, obid());
                    pg8::EpiInProj E3{COLS, (unsigned char*)GB, SSQ, (const float*)(ws + WS_COS), (const float*)(ws + WS_SIN), HROWS, 0};
                    pg8::gemm_phase<pg8::EpiInProj>(lds, g3, S3, E3);
                }
            }
        }
    }
}

extern "C" void kernel_launch(void* const* d_in, const int* in_sizes, int n_in, void* d_out, int out_size, void* d_ws, size_t ws_size, hipStream_t stream) {
    static int grid = 0;
    if (grid == 0) {
        if (n_in != 17 || out_size != MTOK * DM || ws_size < WS_END) { fprintf(stderr, "kernel_launch: unexpected shapes (n_in %d out %d ws %zu)\n", n_in, out_size, ws_size); grid = -1; return; }
        int dev = 0, cus = 0, per_cu = 0;
        (void)hipGetDevice(&dev); (void)hipDeviceGetAttribute(&cus, hipDeviceAttributeMultiprocessorCount, dev);
        (void)hipFuncSetAttribute((const void*)fwd_kernel, hipFuncAttributeMaxDynamicSharedMemorySize, LDS_BYTES);
        if (hipOccupancyMaxActiveBlocksPerMultiprocessor(&per_cu, (const void*)fwd_kernel, 512, LDS_BYTES) != hipSuccess || per_cu < 1) per_cu = 1;
        (void)hipGetLastError();
        if (cus <= 0) cus = 256;
        grid = cus * per_cu;
    }
    if (grid < 0) return;
    Params p{};
    for (int i = 0; i < 17; ++i) p.in[i] = (const float*)d_in[i];
    p.out = (float*)d_out; p.ws = (unsigned char*)d_ws;
    for (int i = 0; i < 64; ++i) p.invf[i] = powf(10000.0f, -((float)i / 63.0f));
#if MK_MULTI
    for (int ph = 0; ph < NPHASE; ++ph) { p.lo = ph; p.hi = ph + 1; hipLaunchKernelGGL(fwd_kernel, dim3(grid), dim3(512), LDS_BYTES, stream, p); }
#else
    p.lo = 0; p.hi = NPHASE;
    void* args[] = {&p};
    hipError_t e = hipLaunchCooperativeKernel((const void*)fwd_kernel, dim3(grid), dim3(512), args, LDS_BYTES, stream);
    if (e != hipSuccess) fprintf(stderr, "cooperative launch failed: %s (grid %d)\n", hipGetErrorString(e), grid);
#endif
}
```
